# Optimizing an MI355X kernel written in HIP

```python
import math
import jax, jax.numpy as jnp
from jax import lax
import numpy as np

D_MODEL = 1024
BATCH = 4
SEQ = 4096
DEPTH = 1

CHUNK = 64
Q_BLOCK = 128
HEAD_DIM = 64
SB_HEADS = 8
SB_WIDTH = SB_HEADS * HEAD_DIM
DF_HEADS = 4
DF_QK_WIDTH = DF_HEADS * 2 * HEAD_DIM
DF_V_DIM = 2 * HEAD_DIM
DF_V_WIDTH = DF_HEADS * DF_V_DIM
IN_WIDTH = 3 * SB_WIDTH + 2 * DF_QK_WIDTH + DF_V_WIDTH
D_FF = 4 * D_MODEL
ROPE_THETA = 10000.0
EPS = 1e-6
NEG_INF = -1e30

kernel_name = "hybrid_stickbreak_diffattn_block"


def rmsnorm(x, g):
    xf = x.astype(jnp.float32)
    y = xf * lax.rsqrt(jnp.mean(xf * xf, axis=-1, keepdims=True) + EPS)
    return (y * g.astype(jnp.float32)).astype(x.dtype)


def rope(x, pos):
    d = x.shape[-1]
    inv_freq = ROPE_THETA ** (-jnp.arange(0, d, 2, dtype=jnp.float32) / d)
    ang = pos.astype(jnp.float32)[..., None] * inv_freq
    cos = jnp.cos(ang)[:, :, None, :]
    sin = jnp.sin(ang)[:, :, None, :]
    x1, x2 = x[..., : d // 2], x[..., d // 2:]
    return jnp.concatenate([x1 * cos - x2 * sin, x1 * sin + x2 * cos], axis=-1)


def stick_breaking_attention(q, k, v):
    b, s, h, d = q.shape
    nb = s // Q_BLOCK
    qf = q.astype(jnp.float32) * (d ** -0.5)
    kf = k.astype(jnp.float32)
    vf = v.astype(jnp.float32)
    k_idx = jnp.arange(s)

    def block(i):
        qb = lax.dynamic_slice_in_dim(qf, i * Q_BLOCK, Q_BLOCK, axis=1)
        q_idx = i * Q_BLOCK + jnp.arange(Q_BLOCK)
        z = jnp.einsum('bqhd,bkhd->bhqk', qb, kf)
        causal = k_idx[None, :] < q_idx[:, None]
        log_1m = jnp.where(causal, jax.nn.log_sigmoid(-z), 0.0)
        after = lax.cumsum(log_1m, axis=3, reverse=True) - log_1m
        w = jnp.where(causal, jnp.exp(jax.nn.log_sigmoid(z) + after), 0.0)
        return jnp.einsum('bhqk,bkhd->bqhd', w, vf)

    out = lax.map(block, jnp.arange(nb))
    return out.transpose(1, 0, 2, 3, 4).reshape(b, s, h, d)


def differential_attention(q1, q2, k1, k2, v, lam):
    b, s, h, d = q1.shape
    nb = s // Q_BLOCK
    scale = d ** -0.5
    vf = v.astype(jnp.float32)
    k_chunk = jnp.arange(s) // CHUNK

    def block(i):
        qb1 = lax.dynamic_slice_in_dim(q1, i * Q_BLOCK, Q_BLOCK, axis=1) * scale
        qb2 = lax.dynamic_slice_in_dim(q2, i * Q_BLOCK, Q_BLOCK, axis=1) * scale
        q_chunk = (i * Q_BLOCK + jnp.arange(Q_BLOCK)) // CHUNK
        allowed = k_chunk[None, :] <= q_chunk[:, None]
        s1 = jnp.where(allowed, jnp.einsum('bqhd,bkhd->bhqk', qb1, k1), NEG_INF)
        s2 = jnp.where(allowed, jnp.einsum('bqhd,bkhd->bhqk', qb2, k2), NEG_INF)
        a = jax.nn.softmax(s1, axis=-1) - lam * jax.nn.softmax(s2, axis=-1)
        return jnp.einsum('bhqk,bkhe->bqhe', a, vf)

    out = lax.map(block, jnp.arange(nb))
    return out.transpose(1, 0, 2, 3, 4).reshape(b, s, h, 2 * d)


def setup_inputs(seed: int = 0) -> dict:
    key = jax.random.key(seed)
    ks = jax.random.split(key, 24)
    f32 = jnp.float32

    def normal(k, shape, std):
        return jax.random.normal(k, shape, f32) * std

    def gain(k, shape):
        return 1.0 + 0.05 * jax.random.normal(k, shape, f32)

    return {
        "x": jax.random.normal(ks[0], (BATCH, SEQ, D_MODEL), f32),
        "c": jax.random.normal(ks[1], (BATCH, D_MODEL), f32),
        "positions": (jnp.arange(SEQ, dtype=jnp.int32)[None, :]
                      + jax.random.randint(ks[2], (BATCH, 1), 0, 4096, dtype=jnp.int32)),
        "w_ada": normal(ks[3], (DEPTH, D_MODEL, 6 * D_MODEL), D_MODEL ** -0.5),
        "b_ada": normal(ks[4], (DEPTH, 6 * D_MODEL), 0.02),
        "g_pre_mix": gain(ks[5], (DEPTH, D_MODEL)),
        "w_in": normal(ks[6], (DEPTH, D_MODEL, IN_WIDTH), D_MODEL ** -0.5),
        "lambda_q1": normal(ks[7], (DEPTH, HEAD_DIM), 0.1),
        "lambda_k1": normal(ks[8], (DEPTH, HEAD_DIM), 0.1),
        "lambda_q2": normal(ks[9], (DEPTH, HEAD_DIM), 0.1),
        "lambda_k2": normal(ks[10], (DEPTH, HEAD_DIM), 0.1),
        "g_subln": gain(ks[11], (DEPTH, DF_V_DIM)),
        "w_branch_sb": normal(ks[12], (DEPTH, SB_WIDTH, D_MODEL), SB_WIDTH ** -0.5),
        "w_branch_df": normal(ks[13], (DEPTH, DF_V_WIDTH, D_MODEL), DF_V_WIDTH ** -0.5),
        "w_gate": normal(ks[14], (DEPTH, D_MODEL, 2 * D_MODEL), D_MODEL ** -0.5),
        "b_gate": normal(ks[15], (DEPTH, 2 * D_MODEL), 0.02),
        "w_out": normal(ks[16], (DEPTH, D_MODEL, D_MODEL), D_MODEL ** -0.5),
        "g_post_mix": gain(ks[17], (DEPTH, D_MODEL)),
        "g_pre_ffn": gain(ks[18], (DEPTH, D_MODEL)),
        "w_ff1": normal(ks[19], (DEPTH, D_MODEL, D_FF), D_MODEL ** -0.5),
        "w_ff2": normal(ks[20], (DEPTH, D_FF, D_MODEL), D_FF ** -0.5),
        "g_post_ffn": gain(ks[21], (DEPTH, D_MODEL)),
    }


def reference(x, c, positions, w_ada, b_ada, g_pre_mix, w_in, lambda_q1, lambda_k1,
              lambda_q2, lambda_k2, g_subln, w_branch_sb, w_branch_df, w_gate, b_gate,
              w_out, g_post_mix, g_pre_ffn, w_ff1, w_ff2, g_post_ffn):
    b, s, _ = x.shape
    for l in range(DEPTH):
        lambda_init = 0.8 - 0.6 * math.exp(-0.3 * l)
        mod = jnp.einsum('bd,de->be', jax.nn.silu(c), w_ada[l]) + b_ada[l]
        sh1, sc1, gt1, sh2, sc2, gt2 = jnp.split(mod[:, None, :], 6, axis=-1)

        h = rmsnorm(x, g_pre_mix[l]) * (1.0 + sc1) + sh1
        proj = jnp.einsum('bsd,de->bse', h, w_in[l])
        q_sb, k_sb, v_sb, q_df, k_df, v_df = jnp.split(
            proj, np.cumsum([SB_WIDTH, SB_WIDTH, SB_WIDTH, DF_QK_WIDTH, DF_QK_WIDTH]).tolist(), axis=-1)

        y_sb = stick_breaking_attention(q_sb.reshape(b, s, SB_HEADS, HEAD_DIM),
                                        k_sb.reshape(b, s, SB_HEADS, HEAD_DIM),
                                        v_sb.reshape(b, s, SB_HEADS, HEAD_DIM))
        y_sb = y_sb.reshape(b, s, SB_WIDTH).astype(x.dtype)

        qd = rope(q_df.astype(jnp.float32).reshape(b, s, 2 * DF_HEADS, HEAD_DIM), positions)
        kd = rope(k_df.astype(jnp.float32).reshape(b, s, 2 * DF_HEADS, HEAD_DIM), positions)
        qd = qd.reshape(b, s, DF_HEADS, 2, HEAD_DIM)
        kd = kd.reshape(b, s, DF_HEADS, 2, HEAD_DIM)
        lam = (jnp.exp(jnp.sum(lambda_q1[l].astype(jnp.float32) * lambda_k1[l].astype(jnp.float32)))
               - jnp.exp(jnp.sum(lambda_q2[l].astype(jnp.float32) * lambda_k2[l].astype(jnp.float32)))
               + lambda_init)
        y_df = differential_attention(qd[..., 0, :], qd[..., 1, :], kd[..., 0, :], kd[..., 1, :],
                                      v_df.reshape(b, s, DF_HEADS, DF_V_DIM), lam)
        y_df = rmsnorm(y_df, g_subln[l]) * (1.0 - lambda_init)
        y_df = y_df.reshape(b, s, DF_V_WIDTH).astype(x.dtype)

        gates = jax.nn.sigmoid(jnp.einsum('bsd,de->bse', h, w_gate[l]) + b_gate[l])
        g_sb, g_df = jnp.split(gates, 2, axis=-1)
        merged = (g_sb * jnp.einsum('bse,ed->bsd', y_sb, w_branch_sb[l])
                  + g_df * jnp.einsum('bse,ed->bsd', y_df, w_branch_df[l]))
        m = jnp.einsum('bsd,de->bse', merged, w_out[l])
        x = x + gt1 * rmsnorm(m, g_post_mix[l])

        h2 = rmsnorm(x, g_pre_ffn[l]) * (1.0 + sc2) + sh2
        f = jnp.square(jax.nn.relu(jnp.einsum('bsd,df->bsf', h2, w_ff1[l])))
        f = jnp.einsum('bsf,fd->bsd', f, w_ff2[l])
        x = x + gt2 * rmsnorm(f, g_post_ffn[l])
    return x
```

```cpp
#include <hip/hip_runtime.h>
#include <hip/hip_cooperative_groups.h>
#include <cstdio>
#include <cstdint>
namespace cg = cooperative_groups;

#define LAS __attribute__((address_space(3)))
typedef unsigned short bf16_t;
typedef short bf16x8 __attribute__((ext_vector_type(8)));
typedef float f32x4 __attribute__((ext_vector_type(4)));
typedef float f32x16 __attribute__((ext_vector_type(16)));
typedef unsigned u32x4 __attribute__((ext_vector_type(4)));
typedef unsigned u32x2 __attribute__((ext_vector_type(2)));
typedef float f32x2_t __attribute__((ext_vector_type(2)));
typedef __bf16 bf16x2_t __attribute__((ext_vector_type(2)));

__device__ __forceinline__ unsigned cvtpk(float lo, float hi) { f32x2_t v = {lo, hi}; bf16x2_t b = __builtin_convertvector(v, bf16x2_t); return __builtin_bit_cast(unsigned, b); }
__device__ __forceinline__ float bflo(unsigned u) { return __uint_as_float(u << 16); }
__device__ __forceinline__ float bfhi(unsigned u) { return __uint_as_float(u & 0xffff0000u); }

constexpr int DM = 1024, SEQ = 4096, NB = 4, M = NB * SEQ, FF = 4096;
constexpr float EPS = 1e-6f;
constexpr float C2 = 0.125f * 1.4426950408889634f;
constexpr float LAMBDA_INIT = 0.2f;

constexpr size_t MiB = 1u << 20;
constexpr size_t WS_CTL = 0, CTL_ZERO_BYTES = 1 * MiB;
constexpr size_t CTL_MOD = 0;
constexpr size_t CTL_RSS1 = 128 * 1024;
constexpr size_t CTL_RSS2 = 192 * 1024;
constexpr size_t CTL_QUEUE = 256 * 1024;
constexpr size_t CTL_RSS3 = 320 * 1024;
constexpr size_t CTL_PCNT = 384 * 1024;
constexpr size_t CTL_BAR = 512 * 1024;
constexpr size_t WS_WCAT = 2 * MiB;
constexpr size_t WS_WBSB = 12 * MiB;
constexpr size_t WS_WBDF = 13 * MiB;
constexpr size_t WS_WOUT = 14 * MiB;
constexpr size_t WS_WFF1 = 16 * MiB;
constexpr size_t WS_WFF2 = 24 * MiB;
constexpr size_t WS_BUFA = 32 * MiB;
constexpr size_t WS_QK = 64 * MiB;
constexpr size_t WS_GATE = 128 * MiB;
constexpr size_t WS_F = 64 * MiB;
constexpr size_t WS_VT = 192 * MiB;
constexpr size_t WS_MG = 224 * MiB;
constexpr size_t WS_END = 256 * MiB;

namespace pg8 {
constexpr int BM = 256, BK = 64, HALF = 128, HTB = HALF * BK * 2, STAGE_BYTES = 8 * HTB, NXCD = 8, WGM = 8;
__host__ __device__ __forceinline__ int lds_byte(int r, int c) { const int st = (r >> 4) * 2 + (c >> 5), rr = r & 15, cc = c & 31, ob = rr * 64 + cc * 2; return st * 1024 + (ob ^ (((ob >> 9) & 1) << 5)); }
__host__ __device__ __forceinline__ void stage_rc(int b, int& R, int& C) { const int st = b / 1024, sb = b % 1024, swz = sb ^ (((sb >> 9) & 1) << 5); R = (st >> 1) * 16 + swz / 64; C = (st & 1) * 32 + (swz % 64) / 2; }
__host__ __device__ __forceinline__ int perm32(int rho) { const int n = rho >> 4, i = rho & 15; return 8 * (i >> 2) + 4 * n + (i & 3); }
struct Unit { int pm, pn; };
struct Gemm { const bf16_t* A; const bf16_t* Bt; int M, N, K; };
struct StaticOrder {
    int nM, nN, nwg, G, c;
    __host__ __device__ void init(int M_, int N_, int G_, int c_) { nM = M_ / BM; nN = N_ / BM; nwg = nM * nN; G = G_; c = c_; }
    __host__ __device__ bool next(int i, Unit& u) const {
        const long L = (long)i * G + c; if (L >= nwg) return false;
        int wgid = (int)L; { const int q = nwg / NXCD, r = nwg % NXCD, xcd = wgid % NXCD, off = wgid / NXCD; wgid = (xcd < r ? xcd * (q + 1) : r * (q + 1) + (xcd - r) * q) + off; }
        const int nig = WGM * nN, gid = wgid / nig, fm = gid * WGM, gsz = (nM - fm) < WGM ? (nM - fm) : WGM;
        u.pm = fm + ((wgid % nig) % gsz); u.pn = (wgid % nig) / gsz; return true;
    }
    __device__ __forceinline__ void a_ready(const Unit&) const {}
    __device__ __forceinline__ void done(const Unit&) const {}
};

struct TwoOrder {
    StaticOrder a, b; int na, dpm, dpn;
    __device__ __forceinline__ bool next(int i, Unit& u) const {
        if (i < na) return a.next(i, u);
        if (!b.next(i - na, u)) return false;
        u.pm += dpm; u.pn += dpn; return true;
    }
    __device__ __forceinline__ void a_ready(const Unit&) const {}
    __device__ __forceinline__ void done(const Unit&) const {}
};
struct PairOrder {
    StaticOrder a; int dpm, dpn;
    __device__ __forceinline__ bool next(int i, Unit& u) const { if (!a.next(i >> 1, u)) return false; if (i & 1) { u.pm += dpm; u.pn += dpn; } return true; }
    __device__ __forceinline__ void a_ready(const Unit&) const {}
    __device__ __forceinline__ void done(const Unit&) const {}
};

struct EpiPlain {
    static constexpr bool PERM = true, AFTER_DRAIN = false;
    bf16_t* O; int ldc;
    __device__ __forceinline__ void operator()(const f32x4 (&acc)[2][2][4][2], const Unit& u, int wr, int wc, int fr, int fq) const {
        const int row0 = u.pm * BM + wr * 64 + fr, col0 = u.pn * BM + wc * 32 + 8 * fq;
#pragma unroll
        for (int ai = 0; ai < 2; ++ai)
#pragma unroll
            for (int m = 0; m < 4; ++m) { bf16_t* rowp = O + (size_t)(row0 + ai * HALF + m * 16) * ldc + col0;
#pragma unroll
                for (int bj = 0; bj < 2; ++bj) { const f32x4 v0 = acc[ai][bj][m][0], v1 = acc[ai][bj][m][1];
                    u32x4 w; w.x = cvtpk(v0[0], v0[1]); w.y = cvtpk(v0[2], v0[3]); w.z = cvtpk(v1[0], v1[1]); w.w = cvtpk(v1[2], v1[3]);
                    *(u32x4*)(rowp + bj * HALF) = w; } }
    }
};
struct EpiRelu2 {
    static constexpr bool PERM = true, AFTER_DRAIN = false;
    bf16_t* O; int ldc;
    __device__ __forceinline__ void operator()(const f32x4 (&acc)[2][2][4][2], const Unit& u, int wr, int wc, int fr, int fq) const {
        const int row0 = u.pm * BM + wr * 64 + fr, col0 = u.pn * BM + wc * 32 + 8 * fq;
#pragma unroll
        for (int ai = 0; ai < 2; ++ai)
#pragma unroll
            for (int m = 0; m < 4; ++m) { bf16_t* rowp = O + (size_t)(row0 + ai * HALF + m * 16) * ldc + col0;
#pragma unroll
                for (int bj = 0; bj < 2; ++bj) { f32x4 v0 = acc[ai][bj][m][0], v1 = acc[ai][bj][m][1];
#pragma unroll
                    for (int k = 0; k < 4; ++k) { const float a = fmaxf(v0[k], 0.f), b = fmaxf(v1[k], 0.f); v0[k] = a * a; v1[k] = b * b; }
                    u32x4 w; w.x = cvtpk(v0[0], v0[1]); w.y = cvtpk(v0[2], v0[3]); w.z = cvtpk(v1[0], v1[1]); w.w = cvtpk(v1[2], v1[3]);
                    *(u32x4*)(rowp + bj * HALF) = w; } }
    }
};
struct EpiSumsq {
    static constexpr bool PERM = true, AFTER_DRAIN = false;
    bf16_t* O; int ldc; float* rss;
    __device__ __forceinline__ void operator()(const f32x4 (&acc)[2][2][4][2], const Unit& u, int wr, int wc, int fr, int fq) const {
        const int row0 = u.pm * BM + wr * 64 + fr, col0 = u.pn * BM + wc * 32 + 8 * fq;
#pragma unroll
        for (int ai = 0; ai < 2; ++ai)
#pragma unroll
            for (int m = 0; m < 4; ++m) { const int row = row0 + ai * HALF + m * 16; bf16_t* rowp = O + (size_t)row * ldc + col0; float s = 0.f;
#pragma unroll
                for (int bj = 0; bj < 2; ++bj) { const f32x4 v0 = acc[ai][bj][m][0], v1 = acc[ai][bj][m][1];
                    s += (v0[0] * v0[0] + v0[1] * v0[1]) + (v0[2] * v0[2] + v0[3] * v0[3]) + (v1[0] * v1[0] + v1[1] * v1[1]) + (v1[2] * v1[2] + v1[3] * v1[3]);
                    u32x4 w; w.x = cvtpk(v0[0], v0[1]); w.y = cvtpk(v0[2], v0[3]); w.z = cvtpk(v1[0], v1[1]); w.w = cvtpk(v1[2], v1[3]);
                    *(u32x4*)(rowp + bj * HALF) = w; }
                s += __shfl_xor(s, 16); s += __shfl_xor(s, 32);
                if (fq == 0) unsafeAtomicAdd(rss + row, s); }
    }
};
struct PanelX {
    float* rss; unsigned* cnt;
    __device__ __forceinline__ void run(const float (&part)[2][4], float (&tot)[2][4], const Unit& u, int wr, int fr, int fq) const {
        const int row0 = u.pm * BM + wr * 64 + fr;
#pragma unroll
        for (int ai = 0; ai < 2; ++ai)
#pragma unroll
            for (int m = 0; m < 4; ++m) { float s = part[ai][m]; s += __shfl_xor(s, 16); s += __shfl_xor(s, 32);
                if (fq == 0) __hip_atomic_fetch_add(rss + row0 + ai * HALF + m * 16, s, __ATOMIC_RELAXED, __HIP_MEMORY_SCOPE_AGENT); }
        asm volatile("s_waitcnt vmcnt(0)" ::: "memory");
        __builtin_amdgcn_s_barrier();
        if (threadIdx.x == 0) {
            unsigned* c = cnt + 64 * u.pm;
            __hip_atomic_fetch_add(c, 1u, __ATOMIC_RELEASE, __HIP_MEMORY_SCOPE_AGENT);
            unsigned sp = 0;
            while (__hip_atomic_load(c, __ATOMIC_RELAXED, __HIP_MEMORY_SCOPE_AGENT) < 4u) { __builtin_amdgcn_s_sleep(1); if (++sp > (1u << 22)) break; }
            __builtin_amdgcn_fence(__ATOMIC_ACQUIRE, "agent");
        }
        asm volatile("s_waitcnt vmcnt(0) lgkmcnt(0)" ::: "memory");
        __builtin_amdgcn_s_barrier();
#pragma unroll
        for (int ai = 0; ai < 2; ++ai)
#pragma unroll
            for (int m = 0; m < 4; ++m) tot[ai][m] = __hip_atomic_load(rss + row0 + ai * HALF + m * 16, __ATOMIC_RELAXED, __HIP_MEMORY_SCOPE_AGENT);
    }
};
struct EpiFinal {
    static constexpr bool PERM = true, AFTER_DRAIN = false;
    float* out; const bf16_t* X1B; const float* mod; const float* g_post; PanelX px;
    __device__ __forceinline__ void operator()(const f32x4 (&acc)[2][2][4][2], const Unit& u, int wr, int wc, int fr, int fq) const {
        const int row0 = u.pm * BM + wr * 64 + fr, col0 = u.pn * BM + wc * 32 + 8 * fq;
        float part[2][4], tot[2][4];
#pragma unroll
        for (int ai = 0; ai < 2; ++ai)
#pragma unroll
            for (int m = 0; m < 4; ++m) { float s = 0.f;
#pragma unroll
                for (int bj = 0; bj < 2; ++bj) { const f32x4 v0 = acc[ai][bj][m][0], v1 = acc[ai][bj][m][1];
                    s += (v0[0] * v0[0] + v0[1] * v0[1]) + (v0[2] * v0[2] + v0[3] * v0[3]) + (v1[0] * v1[0] + v1[1] * v1[1]) + (v1[2] * v1[2] + v1[3] * v1[3]); }
                part[ai][m] = s; }
        px.run(part, tot, u, wr, fr, fq);
        const float* gtp = mod + ((u.pm * BM) >> 12) * 6144 + 5120 + col0;
#pragma unroll
        for (int bj = 0; bj < 2; ++bj) { f32x4 gg[2];
#pragma unroll
            for (int n = 0; n < 2; ++n) gg[n] = *(const f32x4*)(gtp + bj * HALF + 4 * n) * *(const f32x4*)(g_post + col0 + bj * HALF + 4 * n);
#pragma unroll
            for (int ai = 0; ai < 2; ++ai)
#pragma unroll
                for (int m = 0; m < 4; ++m) { const float rstd = __builtin_amdgcn_rsqf(tot[ai][m] * (1.f / 1024.f) + 1e-6f);
                    const size_t off = (size_t)(row0 + ai * HALF + m * 16) * 1024 + col0 + bj * HALF; float* op = out + off;
                    const u32x4 xb = *(const u32x4*)(X1B + off);
                    const f32x4 x0 = {bflo(xb.x), bfhi(xb.x), bflo(xb.y), bfhi(xb.y)}, x1v = {bflo(xb.z), bfhi(xb.z), bflo(xb.w), bfhi(xb.w)};
                    *(f32x4*)(op) = x0 + gg[0] * (acc[ai][bj][m][0] * rstd); *(f32x4*)(op + 4) = x1v + gg[1] * (acc[ai][bj][m][1] * rstd);
                    if (m & 1) asm volatile("" ::: "memory"); } }
    }
};
struct EpiMid {
    static constexpr bool PERM = true, AFTER_DRAIN = false;
    const float* x; bf16_t* X1B; bf16_t* H2; const float* mod; const float* g_post; const float* g_pre; PanelX px1, px2;
    __device__ __forceinline__ void operator()(f32x4 (&acc)[2][2][4][2], const Unit& u, int wr, int wc, int fr, int fq) const {
        const int row0 = u.pm * BM + wr * 64 + fr, col0 = u.pn * BM + wc * 32 + 8 * fq;
        float part[2][4], tot[2][4];
#pragma unroll
        for (int ai = 0; ai < 2; ++ai)
#pragma unroll
            for (int m = 0; m < 4; ++m) { float s = 0.f;
#pragma unroll
                for (int bj = 0; bj < 2; ++bj) { const f32x4 v0 = acc[ai][bj][m][0], v1 = acc[ai][bj][m][1];
                    s += (v0[0] * v0[0] + v0[1] * v0[1]) + (v0[2] * v0[2] + v0[3] * v0[3]) + (v1[0] * v1[0] + v1[1] * v1[1]) + (v1[2] * v1[2] + v1[3] * v1[3]); }
                part[ai][m] = s; }
        px1.run(part, tot, u, wr, fr, fq);
        const float* mb = mod + ((u.pm * BM) >> 12) * 6144;
#pragma unroll
        for (int ai = 0; ai < 2; ++ai)
#pragma unroll
            for (int m = 0; m < 4; ++m) part[ai][m] = 0.f;
#pragma unroll
        for (int bj = 0; bj < 2; ++bj) { f32x4 gg[2];
#pragma unroll
            for (int n = 0; n < 2; ++n) gg[n] = *(const f32x4*)(mb + 2048 + col0 + bj * HALF + 4 * n) * *(const f32x4*)(g_post + col0 + bj * HALF + 4 * n);
#pragma unroll
            for (int ai = 0; ai < 2; ++ai)
#pragma unroll
                for (int m = 0; m < 4; ++m) { const float rstd = __builtin_amdgcn_rsqf(tot[ai][m] * (1.f / 1024.f) + 1e-6f);
                    const size_t off = (size_t)(row0 + ai * HALF + m * 16) * 1024 + col0 + bj * HALF;
#pragma unroll
                    for (int n = 0; n < 2; ++n) { const f32x4 v = *(const f32x4*)(x + off + 4 * n) + gg[n] * (acc[ai][bj][m][n] * rstd); acc[ai][bj][m][n] = v;
                        part[ai][m] += (v[0] * v[0] + v[1] * v[1]) + (v[2] * v[2] + v[3] * v[3]); }
                    { const f32x4 v0 = acc[ai][bj][m][0], v1 = acc[ai][bj][m][1]; u32x4 w; w.x = cvtpk(v0[0], v0[1]); w.y = cvtpk(v0[2], v0[3]); w.z = cvtpk(v1[0], v1[1]); w.w = cvtpk(v1[2], v1[3]); *(u32x4*)(X1B + off) = w; }
                    if (m & 1) asm volatile("" ::: "memory"); } }
        px2.run(part, tot, u, wr, fr, fq);
#pragma unroll
        for (int bj = 0; bj < 2; ++bj) { f32x4 gg[2], sh[2];
#pragma unroll
            for (int n = 0; n < 2; ++n) { gg[n] = (*(const f32x4*)(mb + 4096 + col0 + bj * HALF + 4 * n) + 1.f) * *(const f32x4*)(g_pre + col0 + bj * HALF + 4 * n); sh[n] = *(const f32x4*)(mb + 3072 + col0 + bj * HALF + 4 * n); }
#pragma unroll
            for (int ai = 0; ai < 2; ++ai)
#pragma unroll
                for (int m = 0; m < 4; ++m) { const float rstd = __builtin_amdgcn_rsqf(tot[ai][m] * (1.f / 1024.f) + 1e-6f);
                    const f32x4 h0 = acc[ai][bj][m][0] * rstd * gg[0] + sh[0], h1 = acc[ai][bj][m][1] * rstd * gg[1] + sh[1];
                    u32x4 w; w.x = cvtpk(h0[0], h0[1]); w.y = cvtpk(h0[2], h0[3]); w.z = cvtpk(h1[0], h1[1]); w.w = cvtpk(h1[2], h1[3]);
                    *(u32x4*)(H2 + (size_t)(row0 + ai * HALF + m * 16) * 1024 + col0 + bj * HALF) = w; } }
    }
};
struct EpiGate {
    static constexpr bool PERM = true, AFTER_DRAIN = false;
    bf16_t* O; const bf16_t* G;
    __device__ __forceinline__ void operator()(f32x4 (&acc)[2][2][4][2], const Unit& u, int wr, int wc, int fr, int fq) const {
        const bool second = u.pm >= 64;
        const int row0 = (u.pm & 63) * BM + wr * 64 + fr, col0 = (u.pn & 3) * BM + wc * 32 + 8 * fq;
#pragma unroll
        for (int ai = 0; ai < 2; ++ai)
#pragma unroll
            for (int m = 0; m < 4; ++m) { const int row = row0 + ai * HALF + m * 16; bf16_t* rowp = O + (size_t)row * 1024 + col0; const bf16_t* gp = G + (size_t)row * 2048 + col0;
#pragma unroll
                for (int bj = 0; bj < 2; ++bj) {
                    const u32x4 d = *(const u32x4*)(gp + 1024 + bj * HALF);
                    f32x4 g0, g1;
                    g0[0] = fmaxf(bflo(d.x), 1e-30f); g0[1] = fmaxf(bfhi(d.x), 1e-30f); g0[2] = fmaxf(bflo(d.y), 1e-30f); g0[3] = fmaxf(bfhi(d.y), 1e-30f);
                    g1[0] = fmaxf(bflo(d.z), 1e-30f); g1[1] = fmaxf(bfhi(d.z), 1e-30f); g1[2] = fmaxf(bflo(d.w), 1e-30f); g1[3] = fmaxf(bfhi(d.w), 1e-30f);
                    if (second) { const f32x4 v0 = acc[ai][bj][m][0] * g0, v1 = acc[ai][bj][m][1] * g1;
                        u32x4 w; w.x = cvtpk(v0[0], v0[1]); w.y = cvtpk(v0[2], v0[3]); w.z = cvtpk(v1[0], v1[1]); w.w = cvtpk(v1[2], v1[3]);
                        *(u32x4*)(rowp + bj * HALF) = w; }
                    else { const u32x4 a = *(const u32x4*)(gp + bj * HALF);
                        f32x4 r0, r1;
                        r0[0] = bflo(a.x) * __builtin_amdgcn_rcpf(g0[0]); r0[1] = bfhi(a.x) * __builtin_amdgcn_rcpf(g0[1]); r0[2] = bflo(a.y) * __builtin_amdgcn_rcpf(g0[2]); r0[3] = bfhi(a.y) * __builtin_amdgcn_rcpf(g0[3]);
                        r1[0] = bflo(a.z) * __builtin_amdgcn_rcpf(g1[0]); r1[1] = bfhi(a.z) * __builtin_amdgcn_rcpf(g1[1]); r1[2] = bflo(a.w) * __builtin_amdgcn_rcpf(g1[2]); r1[3] = bfhi(a.w) * __builtin_amdgcn_rcpf(g1[3]);
                        acc[ai][bj][m][0] *= r0; acc[ai][bj][m][1] *= r1; } }
                if (m & 1) asm volatile("" ::: "memory"); }
    }
};
struct EpiProj {
    static constexpr bool PERM = true, AFTER_DRAIN = false;
    bf16_t* QK; bf16_t* G; const float* b_gate; const int* pos; bf16_t* VT;
    __device__ __forceinline__ void operator()(const f32x4 (&acc)[2][2][4][2], const Unit& u, int wr, int wc, int fr, int fq) const {
        if (u.pm < 0) {
            const int vr0 = (u.pm + 44) * BM + wr * 64 + fr, vc0 = (u.pn - 60) * BM + wc * 32 + 8 * fq;
#pragma unroll
            for (int ai = 0; ai < 2; ++ai)
#pragma unroll
                for (int m = 0; m < 4; ++m) { bf16_t* rowp = VT + (size_t)(vr0 + ai * HALF + m * 16) * 16384 + vc0;
#pragma unroll
                    for (int bj = 0; bj < 2; ++bj) { const f32x4 v0 = acc[ai][bj][m][0], v1 = acc[ai][bj][m][1];
                        u32x4 w; w.x = cvtpk(v0[0], v0[1]); w.y = cvtpk(v0[2], v0[3]); w.z = cvtpk(v1[0], v1[1]); w.w = cvtpk(v1[2], v1[3]);
                        *(u32x4*)(rowp + bj * HALF) = w; } }
            return;
        }
        const int row0 = u.pm * BM + wr * 64 + fr, colt = u.pn * BM, cl = wc * 32 + 8 * fq;
        if (colt >= 2048) {
            const int gc = colt - 2048 + cl;
            f32x4 bv[2][2];
#pragma unroll
            for (int bj = 0; bj < 2; ++bj)
#pragma unroll
                for (int n = 0; n < 2; ++n) bv[bj][n] = *(const f32x4*)(b_gate + gc + bj * HALF + 4 * n);
#pragma unroll
            for (int ai = 0; ai < 2; ++ai)
#pragma unroll
                for (int m = 0; m < 4; ++m) { bf16_t* rowp = G + (size_t)(row0 + ai * HALF + m * 16) * 2048 + gc;
#pragma unroll
                    for (int bj = 0; bj < 2; ++bj) { f32x4 v0 = acc[ai][bj][m][0] + bv[bj][0], v1 = acc[ai][bj][m][1] + bv[bj][1];
#pragma unroll
                        for (int k = 0; k < 4; ++k) { v0[k] = __builtin_amdgcn_rcpf(1.f + __expf(-v0[k])); v1[k] = __builtin_amdgcn_rcpf(1.f + __expf(-v1[k])); }
                        u32x4 w; w.x = cvtpk(v0[0], v0[1]); w.y = cvtpk(v0[2], v0[3]); w.z = cvtpk(v1[0], v1[1]); w.w = cvtpk(v1[2], v1[3]);
                        *(u32x4*)(rowp + bj * HALF) = w; } }
        } else if (colt >= 1024) {
            const float sc = (colt < 1536) ? C2 : 1.f;
            const int i0 = 16 * (wc & 1) + 4 * fq;
            float inv[4];
#pragma unroll
            for (int j = 0; j < 4; ++j) inv[j] = __builtin_amdgcn_exp2f(-(float)(i0 + j) * 0.41524101186092029f);
#pragma unroll
            for (int ai = 0; ai < 2; ++ai)
#pragma unroll
                for (int m = 0; m < 4; ++m) { const int row = row0 + ai * HALF + m * 16; const float p = (float)pos[row]; bf16_t* rowp = QK + (size_t)row * 2048 + colt + cl;
                    float cs[4], sn[4];
#pragma unroll
                    for (int j = 0; j < 4; ++j) { const float ang = p * inv[j]; const float k = rintf(ang * 0.15915494309189535f);
                        float r = fmaf(-k, 6.28125f, ang); r = fmaf(-k, 1.9353071795864769e-3f, r); cs[j] = __cosf(r) * sc; sn[j] = __sinf(r) * sc; }
#pragma unroll
                    for (int bj = 0; bj < 2; ++bj) { const f32x4 v0 = acc[ai][bj][m][0], v1 = acc[ai][bj][m][1];
                        u32x4 w;
                        w.x = cvtpk(v0[0] * cs[0] - v0[1] * sn[0], v0[0] * sn[0] + v0[1] * cs[0]);
                        w.y = cvtpk(v0[2] * cs[1] - v0[3] * sn[1], v0[2] * sn[1] + v0[3] * cs[1]);
                        w.z = cvtpk(v1[0] * cs[2] - v1[1] * sn[2], v1[0] * sn[2] + v1[1] * cs[2]);
                        w.w = cvtpk(v1[2] * cs[3] - v1[3] * sn[3], v1[2] * sn[3] + v1[3] * cs[3]);
                        *(u32x4*)(rowp + bj * HALF) = w; } }
        } else {
            const float sc = (colt < 512) ? C2 : 1.f;
#pragma unroll
            for (int ai = 0; ai < 2; ++ai)
#pragma unroll
                for (int m = 0; m < 4; ++m) { bf16_t* rowp = QK + (size_t)(row0 + ai * HALF + m * 16) * 2048 + colt + cl;
#pragma unroll
                    for (int bj = 0; bj < 2; ++bj) { const f32x4 v0 = acc[ai][bj][m][0] * sc, v1 = acc[ai][bj][m][1] * sc;
                        u32x4 w; w.x = cvtpk(v0[0], v0[1]); w.y = cvtpk(v0[2], v0[3]); w.z = cvtpk(v1[0], v1[1]); w.w = cvtpk(v1[2], v1[3]);
                        *(u32x4*)(rowp + bj * HALF) = w; } }
        }
    }
};

template <class E> struct EpiKeep { static __device__ __forceinline__ bool keep(const Unit&) { return false; } };
struct EpiGate;
template <> struct EpiKeep<EpiGate> { static __device__ __forceinline__ bool keep(const Unit& u) { return u.pm < 64; } };
template <class Epi, class Sched, bool ALIGN_EPI = false, bool SP2 = false>
__device__ __forceinline__ void gemm_phase(LAS unsigned char* lds, const Gemm g, const Sched& S, const Epi& E) {
    int tid = threadIdx.x; asm volatile("" : "+v"(tid));
    const int wid = __builtin_amdgcn_readfirstlane(tid >> 6), lane = tid & 63, wr = wid >> 2, wc = wid & 3, fr = lane & 15, fq = lane >> 4;
    const int K = g.K, nt = K / BK;
    unsigned voffA[2], voffB[2];
#pragma unroll
    for (int i = 0; i < 2; ++i) { int R, C; stage_rc(tid * 16 + i * 8192, R, C); const int Rb = Epi::PERM ? ((R & ~31) + perm32(R & 31)) : R;
        voffA[i] = (unsigned)(R * K + C) * 2u; voffB[i] = (unsigned)(Rb * K + C) * 2u; }
    const size_t kstep = (size_t)(BK * 2);
    const size_t hstep = (size_t)HALF * K * 2;
    const size_t tstep = 2 * hstep;
    const unsigned ldsw = (unsigned)wid * 1024u;
    const int aoff = lds_byte(wr * 64 + fr, fq * 8), boff = lds_byte(wc * 32 + fr, fq * 8);
#define PG8_SA(b, h) (((b) * 2 + (h)) * HTB)
#define PG8_SB(b, h) ((4 + (b) * 2 + (h)) * HTB)
#define PG8_STAGE(bufoff, gbase, voff) do { _Pragma("unroll") for (int _i = 0; _i < 2; ++_i) \
        __builtin_amdgcn_global_load_lds((const unsigned*)((const char*)(gbase) + (voff)[_i]), (LAS unsigned*)(lds + (bufoff) + ldsw + _i * 8192), 16, 0, 0); } while (0)
#define PG8_LDA(dst, b, h) do { _Pragma("unroll") for (int m = 0; m < 4; ++m) _Pragma("unroll") for (int k = 0; k < 2; ++k) dst[m][k] = *(const LAS bf16x8*)(lds + PG8_SA(b, h) + aoff + m * 2048 + k * 1024); } while (0)
#define PG8_LDB(dst, b, h) do { _Pragma("unroll") for (int n = 0; n < 2; ++n) _Pragma("unroll") for (int k = 0; k < 2; ++k) dst[n][k] = *(const LAS bf16x8*)(lds + PG8_SB(b, h) + boff + n * 2048 + k * 1024); } while (0)
#define PG8_MMA(ai, bj, At, Bt) do { __builtin_amdgcn_s_setprio(1); _Pragma("unroll") for (int m = 0; m < 4; ++m) _Pragma("unroll") for (int n = 0; n < 2; ++n) _Pragma("unroll") for (int k = 0; k < 2; ++k) \
        acc[ai][bj][m][n] = __builtin_amdgcn_mfma_f32_16x16x32_bf16(Bt[n][k], At[m][k], acc[ai][bj][m][n], 0, 0, 0); __builtin_amdgcn_s_setprio(0); } while (0)
#define PG8_WAIT_V(n) asm volatile("s_waitcnt vmcnt(" #n ")" ::: "memory")
#define PG8_WAIT_L(n) asm volatile("s_waitcnt lgkmcnt(" #n ")" ::: "memory")
#define PG8_BAR __builtin_amdgcn_s_barrier()
#define PG8_SCHED __builtin_amdgcn_sched_barrier(0)
    Unit cur, nxt; int ui = 0;
    if (!S.next(0, cur)) return;
    f32x4 acc[2][2][4][2];
#pragma unroll
    for (int a = 0; a < 2; ++a)
#pragma unroll
        for (int b = 0; b < 2; ++b)
#pragma unroll
            for (int m = 0; m < 4; ++m)
#pragma unroll
                for (int n = 0; n < 2; ++n) acc[a][b][m][n] = (f32x4){0.f, 0.f, 0.f, 0.f};
    bf16x8 At[4][2], B0[2][2], B1[2][2];
    const char* cA = (const char*)g.A + (size_t)cur.pm * tstep; const char* cB = (const char*)g.Bt + (size_t)cur.pn * tstep;
    S.a_ready(cur);
    if constexpr (SP2) {
        PG8_STAGE(PG8_SB(0, 0), cB, voffB); PG8_STAGE(PG8_SB(0, 1), cB + hstep, voffB); PG8_STAGE(PG8_SA(0, 0), cA, voffA); PG8_STAGE(PG8_SA(0, 1), cA + hstep, voffA);
        if (wr == 1) PG8_BAR;
        PG8_WAIT_V(2); PG8_BAR;
        PG8_STAGE(PG8_SB(1, 0), cB + kstep, voffB); PG8_STAGE(PG8_SA(1, 0), cA + kstep, voffA); PG8_STAGE(PG8_SB(1, 1), cB + hstep + kstep, voffB);
        PG8_WAIT_V(6); PG8_BAR;
    } else {
        PG8_STAGE(PG8_SB(0, 0), cB, voffB); PG8_STAGE(PG8_SA(0, 0), cA, voffA); PG8_STAGE(PG8_SB(0, 1), cB + hstep, voffB); PG8_STAGE(PG8_SA(0, 1), cA + hstep, voffA);
        if (wr == 1) PG8_BAR;
        PG8_WAIT_V(4); PG8_BAR;
        PG8_STAGE(PG8_SB(1, 0), cB + kstep, voffB); PG8_STAGE(PG8_SA(1, 0), cA + kstep, voffA); PG8_STAGE(PG8_SB(1, 1), cB + hstep + kstep, voffB);
        PG8_WAIT_V(6); PG8_BAR;
    }
    for (;;) {
        const bool has_next = S.next(ui + 1, nxt);
        const char* nA = has_next ? (const char*)g.A + (size_t)nxt.pm * tstep : cA; const char* nB = has_next ? (const char*)g.Bt + (size_t)nxt.pn * tstep : cB;
        for (int t = 0; t < nt; t += 2) {
            const bool last = (t == nt - 2);
            const char* a1 = cA + (size_t)(t + 1) * kstep;
            const char* a2 = last ? nA : cA + (size_t)(t + 2) * kstep; const char* b2 = last ? nB : cB + (size_t)(t + 2) * kstep;
            const char* a3 = a2 + kstep; const char* b3 = b2 + kstep;
            if (last && has_next) S.a_ready(nxt);
            if constexpr (SP2) {
            PG8_LDB(B0, 0, 0); PG8_LDB(B1, 0, 1); PG8_SCHED; PG8_LDA(At, 0, 0); PG8_STAGE(PG8_SA(1, 1), a1 + hstep, voffA);
            PG8_WAIT_V(8); PG8_WAIT_L(0); PG8_BAR; PG8_MMA(0, 0, At, B0); PG8_MMA(0, 1, At, B1); PG8_BAR; PG8_SCHED;
            PG8_LDA(At, 0, 1); PG8_STAGE(PG8_SB(0, 0), b2, voffB); PG8_STAGE(PG8_SB(0, 1), b2 + hstep, voffB); PG8_STAGE(PG8_SA(0, 0), a2, voffA);
            PG8_WAIT_V(8); PG8_WAIT_L(0); PG8_BAR; PG8_MMA(1, 0, At, B0); PG8_MMA(1, 1, At, B1); PG8_BAR; PG8_SCHED;
            PG8_LDB(B0, 1, 0); PG8_LDB(B1, 1, 1); PG8_SCHED; PG8_LDA(At, 1, 0); PG8_STAGE(PG8_SA(0, 1), a2 + hstep, voffA);
            PG8_WAIT_V(8); PG8_WAIT_L(0); PG8_BAR; PG8_MMA(0, 0, At, B0); PG8_MMA(0, 1, At, B1); PG8_BAR; PG8_SCHED;
            PG8_LDA(At, 1, 1); PG8_STAGE(PG8_SB(1, 0), b3, voffB); PG8_STAGE(PG8_SB(1, 1), b3 + hstep, voffB); PG8_STAGE(PG8_SA(1, 0), a3, voffA);
            PG8_WAIT_V(8); PG8_WAIT_L(0); PG8_BAR; PG8_MMA(1, 0, At, B0); PG8_MMA(1, 1, At, B1); PG8_BAR; PG8_SCHED;
            } else {
            PG8_LDB(B0, 0, 0); PG8_SCHED; PG8_LDA(At, 0, 0); PG8_STAGE(PG8_SA(1, 1), a1 + hstep, voffA);
            PG8_WAIT_L(8); PG8_BAR; PG8_WAIT_L(0); PG8_MMA(0, 0, At, B0); PG8_BAR; PG8_SCHED;
            PG8_LDB(B1, 0, 1); PG8_STAGE(PG8_SB(0, 0), b2, voffB);
            PG8_BAR; PG8_WAIT_L(0); PG8_MMA(0, 1, At, B1); PG8_BAR;
            PG8_LDA(At, 0, 1); PG8_STAGE(PG8_SA(0, 0), a2, voffA);
            PG8_BAR; PG8_WAIT_L(0); PG8_MMA(1, 0, At, B0); PG8_BAR; PG8_SCHED;
            PG8_STAGE(PG8_SB(0, 1), b2 + hstep, voffB);
            PG8_WAIT_V(6); PG8_BAR; PG8_MMA(1, 1, At, B1); PG8_BAR;
            PG8_LDB(B0, 1, 0); PG8_SCHED; PG8_LDA(At, 1, 0); PG8_STAGE(PG8_SA(0, 1), a2 + hstep, voffA);
            PG8_WAIT_L(8); PG8_BAR; PG8_WAIT_L(0); PG8_MMA(0, 0, At, B0); PG8_BAR; PG8_SCHED;
            PG8_LDB(B1, 1, 1); PG8_STAGE(PG8_SB(1, 0), b3, voffB);
            PG8_BAR; PG8_WAIT_L(0); PG8_MMA(0, 1, At, B1); PG8_BAR;
            PG8_LDA(At, 1, 1); PG8_STAGE(PG8_SA(1, 0), a3, voffA);
            PG8_BAR; PG8_WAIT_L(0); PG8_MMA(1, 0, At, B0); PG8_BAR; PG8_SCHED;
            PG8_STAGE(PG8_SB(1, 1), b3 + hstep, voffB);
            PG8_WAIT_V(6); PG8_BAR; PG8_MMA(1, 1, At, B1); PG8_BAR;
            }
        }
        if constexpr (ALIGN_EPI) { if (wr == 0) PG8_BAR; }
        if constexpr (!Epi::AFTER_DRAIN) { E(acc, cur, wr, wc, fr, fq); S.done(cur); }
        if (!has_next) break;
        if (!EpiKeep<Epi>::keep(cur)) {
#pragma unroll
        for (int a = 0; a < 2; ++a)
#pragma unroll
            for (int b = 0; b < 2; ++b)
#pragma unroll
                for (int m = 0; m < 4; ++m)
#pragma unroll
                    for (int n = 0; n < 2; ++n) acc[a][b][m][n] = (f32x4){0.f, 0.f, 0.f, 0.f};
        }
        cur = nxt; cA = nA; cB = nB; ++ui;
        if constexpr (ALIGN_EPI) { if (wr == 1) PG8_BAR; }
    }
    PG8_WAIT_V(0);
    if constexpr (!ALIGN_EPI) { if (wr == 0) PG8_BAR; }
    PG8_BAR;
#undef PG8_SA
#undef PG8_SB
#undef PG8_STAGE
#undef PG8_LDA
#undef PG8_LDB
#undef PG8_MMA
#undef PG8_WAIT_V
#undef PG8_WAIT_L
#undef PG8_BAR
#undef PG8_SCHED
}
}

namespace att {
constexpr int KROW = 144, VROW = 144, BUF = 36864, K2OFF = 9216, VOFF = 18432;
constexpr int QKP = 2048;
constexpr float SB_EXIT = 1.0e-38f;

__device__ __forceinline__ float partner(float v) {
    const unsigned own = __float_as_uint(v);
    auto rr = __builtin_amdgcn_permlane32_swap(own, own, false, false);
    const unsigned a = rr[0], b = rr[1];
    return __uint_as_float(a == own ? b : a);
}
__device__ __forceinline__ bf16x8 pack8(float a0, float a1, float a2, float a3, float a4, float a5, float a6, float a7) {
    u32x4 w; w.x = cvtpk(a0, a1); w.y = cvtpk(a2, a3); w.z = cvtpk(a4, a5); w.w = cvtpk(a6, a7); return __builtin_bit_cast(bf16x8, w);
}
#define MFMA32(a, b, c) __builtin_amdgcn_mfma_f32_32x32x16_bf16((a), (b), (c), 0, 0, 0)
__device__ __forceinline__ float max3f(float a, float b, float c) { float r; asm("v_max3_f32 %0, %1, %2, %3" : "=v"(r) : "v"(a), "v"(b), "v"(c)); return r; }
constexpr float DF_THR = 8.f;

constexpr int KBUF = 18432, VOFF0 = 2 * KBUF, VBUF = 128 * VROW, FLAGS_OFF = VOFF0 + 3 * VBUF;
template <bool DF>
__device__ __forceinline__ void attn_unit(LAS unsigned char* lds, const bf16_t* __restrict__ QK, const bf16_t* __restrict__ VT, bf16_t* __restrict__ Y,
                                          int b, int h, int qb, float lam, const float* __restrict__ g_subln) {
    int tid = threadIdx.x; asm volatile("" : "+v"(tid));
    const int lane = tid & 63, wid = __builtin_amdgcn_readfirstlane(tid >> 6), r32 = lane & 31, hi = lane >> 5;
    const int sub = wid >> 2, wq = wid & 3;
    const int t0 = qb * 128 + wq * 32;
    const size_t tokbase = (size_t)b * SEQ;
    const int qcol = (DF ? 1024 : 0) + (2 * h + sub) * 64;
    const int kcol = (DF ? 1536 : 512) + h * 128;
    const int vrow0 = (DF ? 512 : 0) + h * 128;
    constexpr int NC = 2;
    constexpr int ND = DF ? 4 : 2;
    const int jt = 2 * qb + 1, jd = t0 >> 6;

    const bf16_t* ksrc[NC]; const bf16_t* vsrc[NC]; unsigned kdst[NC], vdst[NC];
#pragma unroll
    for (int i = 0; i < NC; ++i) {
        const int cid = tid + 512 * i;
        { const int key = cid >> 4, c = cid & 15; ksrc[i] = QK + (tokbase + key) * QKP + kcol + 8 * c; kdst[i] = (unsigned)((c >> 3) * K2OFF + key * KROW + (c & 7) * 16); }
        const int d = cid >> 3, c = cid & 7; vsrc[i] = VT + (size_t)(vrow0 + d) * M + tokbase + 8 * c; vdst[i] = (unsigned)(VOFF0 + d * VROW + (c >> 1) * 32 + (c & 1) * 8);
    }
    u32x4 kA[NC], vA[NC], kB[NC], vB[NC];
#define ATT_GLOAD(KS, VS, j) do { _Pragma("unroll") for (int i_ = 0; i_ < NC; ++i_) { KS[i_] = *(const u32x4*)(ksrc[i_] + (size_t)(j) * 64 * QKP); VS[i_] = *(const u32x4*)(vsrc[i_] + (j) * 64); } } while (0)
#define ATT_LSTORE(kbo, vbo, KS, VS) do { _Pragma("unroll") for (int i_ = 0; i_ < NC; ++i_) { *(LAS u32x4*)(lds + (kbo) + kdst[i_]) = KS[i_]; \
        *(LAS u32x2*)(lds + (vbo) + vdst[i_]) = (u32x2){VS[i_].x, VS[i_].y}; *(LAS u32x2*)(lds + (vbo) + vdst[i_] + 16) = (u32x2){VS[i_].z, VS[i_].w}; } } while (0)
#define ATT_VFRAG(dst, vbase, dd0) do { _Pragma("unroll") for (int i_ = 0; i_ < 8; ++i_) dst[i_] = *(const LAS bf16x8*)((vbase) + ((dd0) + (i_ >> 2)) * 32 * VROW + (i_ & 3) * 32); } while (0)

    bf16x8 qf[4];
    { const bf16_t* Qp = QK + (tokbase + t0 + r32) * QKP + qcol + hi * 8;
#pragma unroll
      for (int d0 = 0; d0 < 4; ++d0) qf[d0] = *(const bf16x8*)(Qp + d0 * 16); }
    ATT_GLOAD(kA, vA, jt);
    ATT_GLOAD(kB, vB, jt - 1);
    f32x16 o[ND];
#pragma unroll
    for (int dd = 0; dd < ND; ++dd) o[dd] = f32x16{};
    float carry = DF ? 0.f : 1.f;
    float lsum = 0.f;
    f32x16 negm = f32x16{};
    bool first = true;
    ATT_LSTORE(0, 0, kA, vA);
#pragma unroll
    for (int d0 = 0; d0 < 4; ++d0) asm volatile("" : "+v"(qf[d0]));
    ATT_GLOAD(kA, vA, (jt >= 2 ? jt - 2 : 0));
    __syncthreads();

    if (wid >= 4) __builtin_amdgcn_s_setprio(1);
    bool done = false;
    volatile LAS unsigned* flags = (volatile LAS unsigned*)(lds + FLAGS_OFF);
    bf16x8 pk[4];
#pragma unroll
    for (int ks = 0; ks < 4; ++ks) pk[ks] = bf16x8{};
    int vcur = 0, vprev = 0;
    auto step = [&](const int j, const int kcur, u32x4 (&KS)[NC], u32x4 (&VS)[NC]) -> bool {
        const int vnext = (vcur == 2 * VBUF) ? 0 : vcur + VBUF;
        if (j <= jd && !done) {
            const LAS unsigned char* Kb = lds + kcur + sub * K2OFF + r32 * KROW + hi * 16;
            const LAS unsigned char* Vb = lds + VOFF0 + vcur + ((DF ? 0 : sub * 64) + r32) * VROW + hi * 16;
            f32x16 p0 = DF ? negm : f32x16{}, p1 = p0;
            bf16x8 kf[8];
#pragma unroll
            for (int d0 = 0; d0 < 4; ++d0) { kf[2 * d0] = *(const LAS bf16x8*)(Kb + d0 * 32); kf[2 * d0 + 1] = *(const LAS bf16x8*)(Kb + 32 * KROW + d0 * 32); }
            __builtin_amdgcn_sched_barrier(0);
#pragma unroll
            for (int d0 = 0; d0 < 4; ++d0) { p0 = MFMA32(kf[2 * d0], qf[d0], p0); p1 = MFMA32(kf[2 * d0 + 1], qf[d0], p1); }
            if (!DF) {
                float be[32], nb[32];
#pragma unroll
                for (int e = 0; e < 32; ++e) { const float z = e < 16 ? p0[e] : p1[e - 16];
                    nb[e] = __builtin_amdgcn_rcpf(1.f + __builtin_amdgcn_exp2f(z)); be[e] = 1.f - nb[e]; }
                if (j == jd) {
                    const int tq = t0 + r32 - 64 * j;
#pragma unroll
                    for (int e = 0; e < 32; ++e) { const int kk = (e & 3) + 8 * ((e & 15) >> 2) + 4 * hi + 32 * (e >> 4); const bool ok = kk < tq;
                        be[e] = ok ? be[e] : 0.f; nb[e] = ok ? nb[e] : 1.f; }
                }
                float SI[9], SIp[9];
                SI[8] = 1.f; SIp[8] = 1.f;
#pragma unroll
                for (int i = 7; i >= 0; --i) SI[i] = SI[i + 1] * ((nb[4 * i] * nb[4 * i + 1]) * (nb[4 * i + 2] * nb[4 * i + 3]));
#pragma unroll
                for (int i = 0; i < 8; ++i) SIp[i] = partner(SI[i]);
                float w[32];
#pragma unroll
                for (int i = 0; i < 8; ++i) {
                    const float a3 = carry * SI[i + 1] * (hi ? SIp[i + 1] : SIp[i]);
                    const float a2 = a3 * nb[4 * i + 3], a1 = a2 * nb[4 * i + 2], a0 = a1 * nb[4 * i + 1];
                    w[4 * i + 3] = be[4 * i + 3] * a3; w[4 * i + 2] = be[4 * i + 2] * a2; w[4 * i + 1] = be[4 * i + 1] * a1; w[4 * i] = be[4 * i] * a0;
                }
                carry *= SI[0] * SIp[0];
                done = __all(carry < SB_EXIT);
                __builtin_amdgcn_sched_barrier(0);
                bf16x8 vfa[8];
                ATT_VFRAG(vfa, Vb, 0);
                bf16x8 pw[4];
#pragma unroll
                for (int ks = 0; ks < 4; ++ks) pw[ks] = pack8(w[8 * ks], w[8 * ks + 1], w[8 * ks + 2], w[8 * ks + 3], w[8 * ks + 4], w[8 * ks + 5], w[8 * ks + 6], w[8 * ks + 7]);
                __builtin_amdgcn_sched_barrier(0);
#pragma unroll
                for (int ks = 0; ks < 4; ++ks) { o[0] = MFMA32(vfa[ks], pw[ks], o[0]); o[1] = MFMA32(vfa[4 + ks], pw[ks], o[1]); }
            } else {
                const LAS unsigned char* Vp = lds + VOFF0 + vprev + r32 * VROW + hi * 16;
                { bf16x8 vfa[8];
                  ATT_VFRAG(vfa, Vp, 0);
#pragma unroll
                  for (int ks = 0; ks < 4; ++ks) { o[0] = MFMA32(vfa[ks], pk[ks], o[0]); o[1] = MFMA32(vfa[4 + ks], pk[ks], o[1]); } }
                float ra = max3f(p0[0], p0[1], p1[0]), rb = max3f(p0[2], p0[3], p1[1]); ra = max3f(ra, p1[2], p1[3]);
#pragma unroll
                for (int r = 4; r < 16; r += 4) { ra = max3f(ra, p0[r], p0[r + 1]); rb = max3f(rb, p0[r + 2], p0[r + 3]); ra = max3f(ra, p1[r], p1[r + 1]); rb = max3f(rb, p1[r + 2], p1[r + 3]); }
                float rm = max3f(ra, rb, rb); rm = max3f(rm, partner(rm), rm);
                const bool need = __any(rm > DF_THR) || first;
                float scl = 1.f;
                if (need) {
                    const float dl = first ? rm : fmaxf(rm, 0.f); carry += dl;
#pragma unroll
                    for (int r = 0; r < 16; ++r) { p0[r] -= dl; p1[r] -= dl; }
#pragma unroll
                    for (int r = 0; r < 16; ++r) negm[r] = -carry;
                    scl = first ? 1.f : __builtin_amdgcn_exp2f(-dl); lsum *= scl;
                    first = false;
                }
                bf16x8 vfb[8];
#define ATT_VFRAG4(ks0) do { _Pragma("unroll") for (int i_ = 0; i_ < 4; ++i_) { const int dd_ = 2 + (i_ >> 1), ks_ = (ks0) + (i_ & 1); vfb[(dd_ - 2) * 4 + ks_] = *(const LAS bf16x8*)(Vp + dd_ * 32 * VROW + ks_ * 32); } } while (0)
                ATT_VFRAG4(0);
                float sa = 0.f, sb = 0.f;
                u32x4 pnw[4];
                typedef __bf16 bf2_t __attribute__((ext_vector_type(2)));
                const bf2_t ones2 = {(__bf16)1.0f, (__bf16)1.0f};
#pragma unroll
                for (int i = 0; i < 8; ++i) {
                    __builtin_amdgcn_sched_barrier(0);
                    if (i == 1) { ATT_VFRAG4(2); __builtin_amdgcn_sched_barrier(0); }
                    if (i & 1) o[ND - 1] = MFMA32(vfb[4 + (i >> 1)], pk[i >> 1], o[ND - 1]); else o[ND - 2] = MFMA32(vfb[i >> 1], pk[i >> 1], o[ND - 2]);
                    __builtin_amdgcn_sched_barrier(0);
                    const int r0 = 4 * (i & 3);
                    const float e0 = __builtin_amdgcn_exp2f(i < 4 ? p0[r0] : p1[r0]), e1 = __builtin_amdgcn_exp2f(i < 4 ? p0[r0 + 1] : p1[r0 + 1]);
                    const float e2 = __builtin_amdgcn_exp2f(i < 4 ? p0[r0 + 2] : p1[r0 + 2]), e3 = __builtin_amdgcn_exp2f(i < 4 ? p0[r0 + 3] : p1[r0 + 3]);
                    const unsigned w0 = cvtpk(e0, e1), w1 = cvtpk(e2, e3);
                    sa = __builtin_amdgcn_fdot2_f32_bf16(__builtin_bit_cast(bf2_t, w0), ones2, sa, false);
                    sb = __builtin_amdgcn_fdot2_f32_bf16(__builtin_bit_cast(bf2_t, w1), ones2, sb, false);
                    pnw[(i >> 2) * 2 + ((i & 3) >> 1)][2 * (i & 1)] = w0; pnw[(i >> 2) * 2 + ((i & 3) >> 1)][2 * (i & 1) + 1] = w1;
                }
                __builtin_amdgcn_sched_barrier(0);
                float s = sa + sb;
                bf16x8 pn[4];
#pragma unroll
                for (int ks = 0; ks < 4; ++ks) pn[ks] = __builtin_bit_cast(bf16x8, pnw[ks]);
#pragma unroll
                for (int ks = 0; ks < 4; ++ks) asm volatile("" : "+v"(pn[ks]));
                asm volatile("" : "+v"(s));
                if (need) {
#pragma unroll
                    for (int dd = 0; dd < ND; ++dd)
#pragma unroll
                        for (int r = 0; r < 16; ++r) o[dd][r] *= scl;
                }
#pragma unroll
                for (int ks = 0; ks < 4; ++ks) pk[ks] = pn[ks];
                lsum += s;
            }
        }
        ATT_LSTORE(kcur ^ KBUF, vnext, KS, VS);
        ATT_GLOAD(KS, VS, (j > 3 ? j - 3 : 0));
        if (!DF) { if (lane == 0) flags[(kcur ? 8 : 0) + wid] = done ? 1u : 0u; }
        __syncthreads();
        vprev = vcur; vcur = vnext;
        if (!DF) {
            const u32x4 f0 = *(const LAS u32x4*)(lds + FLAGS_OFF + (kcur ? 32 : 0)), f1 = *(const LAS u32x4*)(lds + FLAGS_OFF + (kcur ? 32 : 0) + 16);
            if ((f0.x & f0.y & f0.z & f0.w & f1.x & f1.y & f1.z & f1.w) != 0u) return true;
        }
        return false;
    };
    for (int j = jt; j >= 0; j -= 2) {
        if (step(j, 0, kB, vB)) break;
        if (j == 0) break;
        if (step(j - 1, KBUF, kA, vA)) break;
    }
    if (DF) {
        const LAS unsigned char* Vp = lds + VOFF0 + vprev + r32 * VROW + hi * 16;
        bf16x8 vfa[8], vfb[8];
        ATT_VFRAG(vfa, Vp, 0); ATT_VFRAG(vfb, Vp, 2);
#pragma unroll
        for (int ks = 0; ks < 4; ++ks) { o[0] = MFMA32(vfa[ks], pk[ks], o[0]); o[1] = MFMA32(vfa[4 + ks], pk[ks], o[1]); }
#pragma unroll
        for (int ks = 0; ks < 4; ++ks) { o[ND - 2] = MFMA32(vfb[ks], pk[ks], o[ND - 2]); o[ND - 1] = MFMA32(vfb[4 + ks], pk[ks], o[ND - 1]); }
        __syncthreads();
    }
    __builtin_amdgcn_s_setprio(0);
#undef ATT_GLOAD
#undef ATT_LSTORE
#undef ATT_VFRAG
#undef ATT_VFRAG4
    if (!DF) {
        bf16_t* yp = Y + (tokbase + t0 + r32) * 512 + (2 * h + sub) * 64 + 4 * hi;
#pragma unroll
        for (int dd = 0; dd < ND; ++dd)
#pragma unroll
            for (int r4 = 0; r4 < 4; ++r4) { u32x2 w; w.x = cvtpk(o[dd][4 * r4], o[dd][4 * r4 + 1]); w.y = cvtpk(o[dd][4 * r4 + 2], o[dd][4 * r4 + 3]); *(u32x2*)(yp + dd * 32 + r4 * 8) = w; }
    } else {
        const float ltot = lsum + partner(lsum);
        const float inv = 1.f / ltot;
        LAS float* X = (LAS float*)lds + (size_t)wq * 4096;
        if (sub == 1) {
            const float f = lam * inv;
#pragma unroll
            for (int dd = 0; dd < ND; ++dd)
#pragma unroll
                for (int r = 0; r < 16; ++r) X[(dd * 32 + (r & 3) + 8 * (r >> 2) + 4 * hi) * 32 + r32] = o[dd][r] * f;
        }
        __syncthreads();
        if (sub == 0) {
            float ss = 0.f;
#pragma unroll
            for (int dd = 0; dd < ND; ++dd)
#pragma unroll
                for (int r = 0; r < 16; ++r) { const float v = o[dd][r] * inv - X[(dd * 32 + (r & 3) + 8 * (r >> 2) + 4 * hi) * 32 + r32]; o[dd][r] = v; ss += v * v; }
            ss += partner(ss);
            const float rstd = __builtin_amdgcn_rsqf(ss * (1.f / 128.f) + EPS) * (1.f - LAMBDA_INIT);
            bf16_t* yp = Y + (size_t)M * 512 + (tokbase + t0 + r32) * 512 + h * 128 + 4 * hi;
#pragma unroll
            for (int dd = 0; dd < ND; ++dd)
#pragma unroll
                for (int r4 = 0; r4 < 4; ++r4) { const f32x4 g = *(const f32x4*)(g_subln + dd * 32 + r4 * 8 + 4 * hi);
                    u32x2 w; w.x = cvtpk(o[dd][4 * r4] * rstd * g[0], o[dd][4 * r4 + 1] * rstd * g[1]); w.y = cvtpk(o[dd][4 * r4 + 2] * rstd * g[2], o[dd][4 * r4 + 3] * rstd * g[3]);
                    *(u32x2*)(yp + dd * 32 + r4 * 8) = w; }
        }
        __syncthreads();
    }
}
}


#define XB_TMO      128
#define XB_XCNT(j)  (256  + 64 * (j))
#define XB_XSUB(j)  (1280 + 64 * (j))
#define XB_XGEN(j)  (2304 + 64 * (j))
#define XB_TOP      3328
#define XB_TOPGEN   3392
#define XCD_BAR_WORDS 3456
#define XB_SPIN_CAP (1u << 21)
__device__ __forceinline__ unsigned xb_ld(unsigned* p)              { return __hip_atomic_load(p, __ATOMIC_RELAXED, __HIP_MEMORY_SCOPE_AGENT); }
__device__ __forceinline__ unsigned xb_add(unsigned* p, unsigned v) { return __hip_atomic_fetch_add(p, v, __ATOMIC_RELAXED, __HIP_MEMORY_SCOPE_AGENT); }
__device__ __forceinline__ unsigned xb_xcc_id() { return (unsigned)__builtin_amdgcn_s_getreg((3 << 11) | 20) & 0xFu; }
#define XB_SPIN(cond, bar) do { unsigned _sp = 0; while (cond) { __builtin_amdgcn_s_sleep(1); \
    if ((++_sp & 255u) == 0u) { if (xb_ld(&(bar)[XB_TMO])) break; if (_sp > XB_SPIN_CAP) { atomicAdd(&(bar)[XB_TMO], 1u); break; } } } } while (0)
struct XcdBarrier { unsigned* bar; unsigned x; volatile LAS unsigned* st; };
__device__ __forceinline__ XcdBarrier xcd_barrier_post(unsigned* bar, volatile LAS unsigned* st) {
    XcdBarrier b; b.bar = bar; b.x = xb_xcc_id(); b.st = st;
    if (threadIdx.x == 0) (void)xb_add(&bar[XB_XCNT(b.x)], 1u);
    return b;
}
__device__ __forceinline__ void xcd_barrier_complete(unsigned* bar, unsigned x, unsigned& nloc, unsigned& nx) {
    const unsigned G = gridDim.x * gridDim.y * gridDim.z;
    unsigned sum, cnt, mine, sp = 0u;
    for (;;) {
        sum = 0u; cnt = 0u; mine = 0u;
#pragma unroll
        for (unsigned j = 0; j < 16; ++j) { const unsigned c = xb_ld(&bar[XB_XCNT(j)]); sum += c; cnt += (c > 0u) ? 1u : 0u; mine = (j == x) ? c : mine; }
        if (sum == G) break;
        __builtin_amdgcn_s_sleep(1);
        if ((++sp & 255u) == 0u) { if (xb_ld(&bar[XB_TMO])) break; if (sp > XB_SPIN_CAP) { atomicAdd(&bar[XB_TMO], 1u); break; } }
    }
    nloc = mine > 0u ? mine : 1u; nx = cnt > 0u ? cnt : 1u;
}
__device__ __forceinline__ void xcd_barrier(const XcdBarrier& b) {
    asm volatile("s_waitcnt vmcnt(0)" ::: "memory");
    __syncthreads();
    if (threadIdx.x == 0) {
        unsigned* bar = b.bar;
        __builtin_amdgcn_s_waitcnt(0);
        unsigned nloc = b.st[0], nx = b.st[1];
        if (nloc == 0u) { xcd_barrier_complete(bar, b.x, nloc, nx); b.st[0] = nloc; b.st[1] = nx; }
        const unsigned old = xb_add(&bar[XB_XSUB(b.x)], 1u);
        const unsigned gen = old / nloc;
        if (old + 1u == (gen + 1u) * nloc) {
            __builtin_amdgcn_fence(__ATOMIC_RELEASE, "agent");
            asm volatile("s_waitcnt vmcnt(0)" ::: "memory");
            const unsigned og = xb_add(&bar[XB_TOP], 1u);
            const unsigned tg = og / nx;
            if (og + 1u == (tg + 1u) * nx) xb_add(&bar[XB_TOPGEN], 1u);
            else XB_SPIN(xb_ld(&bar[XB_TOPGEN]) == tg, bar);
            __builtin_amdgcn_fence(__ATOMIC_ACQUIRE, "agent");
            xb_add(&bar[XB_XGEN(b.x)], 1u);
            asm volatile("s_waitcnt vmcnt(0)" ::: "memory");
        } else {
            XB_SPIN(xb_ld(&bar[XB_XGEN(b.x)]) == gen, bar);
            __builtin_amdgcn_fence(__ATOMIC_ACQUIRE, "agent");
            asm volatile("s_waitcnt vmcnt(0)" ::: "memory");
        }
    }
    __syncthreads();
}

constexpr int NWAVES = 8, NPHASE = 10;
#ifndef PROBE_REPS
#define PROBE_REPS 0
#define PROBE_MASK 0x8
#endif
constexpr int LDS_BYTES = 147456;
constexpr int MISC_OFF = 131072;

struct Args { const void* in[22]; float* out; unsigned char* ws; int ph_lo, ph_hi; };

__device__ __forceinline__ float wave_sum(float v) {
#pragma unroll
    for (int o = 1; o < 64; o <<= 1) v += __shfl_xor(v, o);
    return v;
}
template <int MAP> __device__ __forceinline__ int rowmap(int n) {
    if (MAP == 0) return n;
    if (MAP == 2) return 2048 + n;
    const int sec = n >> 9, r = n & 511;
    if (sec <= 1) return n;
    if (sec == 2) return 4096 + r;
    if (sec == 5) return 4608 + r;
    const int e = r >> 6, d = r & 63, p = (d < 32) ? 2 * d : 2 * (d - 32) + 1;
    return (sec == 3 ? 1024 : 1536) + e * 64 + p;
}
template <int MAP> __device__ __forceinline__ void transpose_item(const float* __restrict__ W, int K, int N, bf16_t* __restrict__ WT, LAS float* scr, int item, int lane) {
    const int nblk = N / 32, kb = item / nblk, nb = item % nblk, k0 = 64 * kb, n0 = 32 * nb;
    { const int kk0 = lane >> 3, c4 = lane & 7; f32x4 v[8];
#pragma unroll
      for (int i = 0; i < 8; ++i) v[i] = *(const f32x4*)(W + (size_t)(k0 + kk0 + 8 * i) * N + n0 + 4 * c4);
#pragma unroll
      for (int i = 0; i < 8; ++i) { LAS float* p = scr + (kk0 + 8 * i) * 33 + 4 * c4; p[0] = v[i].x; p[1] = v[i].y; p[2] = v[i].z; p[3] = v[i].w; } }
    asm volatile("s_waitcnt lgkmcnt(0)" ::: "memory");
    const int c = lane & 7;
#pragma unroll
    for (int j = 0; j < 4; ++j) { const int n = (lane >> 3) + 8 * j; const LAS float* s = scr + (8 * c) * 33 + n;
        u32x4 o; o.x = cvtpk(s[0 * 33], s[1 * 33]); o.y = cvtpk(s[2 * 33], s[3 * 33]); o.z = cvtpk(s[4 * 33], s[5 * 33]); o.w = cvtpk(s[6 * 33], s[7 * 33]);
        *(u32x4*)(WT + (size_t)rowmap<MAP>(n0 + n) * K + k0 + 8 * c) = o; }
    asm volatile("s_waitcnt lgkmcnt(0)" ::: "memory");
}

__global__ void __launch_bounds__(NWAVES * 64, 2) fwd_kernel(Args args) {
    extern __shared__ __attribute__((aligned(16))) unsigned char lds_raw[];
    LAS unsigned char* lds = (LAS unsigned char*)lds_raw;
    const int tid0 = threadIdx.x, wave = __builtin_amdgcn_readfirstlane(tid0 >> 6);
    const int G = gridDim.x, bx = blockIdx.x;
    const int vcu = (G % 8 == 0) ? (bx % 8) * (G / 8) + bx / 8 : bx;
    const int gw = vcu * NWAVES + wave, NGW = G * NWAVES;

    const float* x = (const float*)args.in[0]; const float* cc = (const float*)args.in[1]; const int* pos = (const int*)args.in[2];
    const float* w_ada = (const float*)args.in[3]; const float* b_ada = (const float*)args.in[4]; const float* g_pre_mix = (const float*)args.in[5];
    const float* w_in = (const float*)args.in[6];
    const float* lq1 = (const float*)args.in[7]; const float* lk1 = (const float*)args.in[8]; const float* lq2 = (const float*)args.in[9]; const float* lk2 = (const float*)args.in[10];
    const float* g_subln = (const float*)args.in[11]; const float* w_bsb = (const float*)args.in[12]; const float* w_bdf = (const float*)args.in[13];
    const float* w_gate = (const float*)args.in[14]; const float* b_gate = (const float*)args.in[15]; const float* w_out = (const float*)args.in[16];
    const float* g_post_mix = (const float*)args.in[17]; const float* g_pre_ffn = (const float*)args.in[18];
    const float* w_ff1 = (const float*)args.in[19]; const float* w_ff2 = (const float*)args.in[20]; const float* g_post_ffn = (const float*)args.in[21];
    float* out = args.out; unsigned char* ws = args.ws;
    float* mod = (float*)(ws + CTL_MOD); float* rss1 = (float*)(ws + CTL_RSS1); float* rss2 = (float*)(ws + CTL_RSS2); unsigned* queue = (unsigned*)(ws + CTL_QUEUE);
    float* rss3 = (float*)(ws + CTL_RSS3); unsigned* pcnt = (unsigned*)(ws + CTL_PCNT);
#define fused ({ int g_ = (int)gridDim.x; asm volatile("" : "+s"(g_)); g_ == 256; })
    bf16_t* WCAT = (bf16_t*)(ws + WS_WCAT); bf16_t* WBSB = (bf16_t*)(ws + WS_WBSB); bf16_t* WBDF = (bf16_t*)(ws + WS_WBDF); bf16_t* WOUT = (bf16_t*)(ws + WS_WOUT);
    bf16_t* WFF1 = (bf16_t*)(ws + WS_WFF1); bf16_t* WFF2 = (bf16_t*)(ws + WS_WFF2);
    bf16_t* BUFA = (bf16_t*)(ws + WS_BUFA); bf16_t* QK = (bf16_t*)(ws + WS_QK); bf16_t* GATE = (bf16_t*)(ws + WS_GATE); bf16_t* FB = (bf16_t*)(ws + WS_F);
    bf16_t* VT = (bf16_t*)(ws + WS_VT); bf16_t* MB = (bf16_t*)(ws + WS_VT); bf16_t* MG = (bf16_t*)(ws + WS_MG); bf16_t* F2 = (bf16_t*)(ws + WS_MG);

    cg::grid_group grid = cg::this_grid();
    const int lo = args.ph_lo, hi_ph = args.ph_hi;
    if (tid0 < 64) ((LAS unsigned*)(lds + MISC_OFF))[tid0] = 0u;
    __syncthreads();
    const XcdBarrier bar = xcd_barrier_post((unsigned*)(ws + CTL_BAR), (volatile LAS unsigned*)(lds + MISC_OFF + 32));
#define GRID_BAR() do { if (lo < 0) grid.sync(); else xcd_barrier(bar); } while (0)
    using SO = pg8::StaticOrder;

    for (int ph = lo; ph < hi_ph; ++ph) {
#if PROBE_REPS
      for (int rep = 0; rep <= ((((PROBE_MASK) >> ph) & 1) ? PROBE_REPS : 0); ++rep) {
        if (rep) GRID_BAR();
#else
      { const int rep = 0;
#endif
        int tid = tid0; asm volatile("" : "+v"(tid));
        const int lane = tid & 63;
        if (ph == 0) {
            const bool gemv = bx < 96;
            for (int cgi = bx; cgi < 96; cgi += G) {
                LAS float* sc = (LAS float*)lds;
                for (int i = tid; i < 4096; i += 512) { const float cv = cc[i]; sc[i] = cv / (1.f + __expf(-cv)); }
                __syncthreads();
                const int col = 64 * cgi + lane; const float* wp = w_ada + (size_t)(128 * wave) * 6144 + col;
                float a0 = 0.f, a1 = 0.f, a2 = 0.f, a3 = 0.f;
#pragma unroll 1
                for (int d0 = 0; d0 < 128; d0 += 32) { float wv[32];
#pragma unroll
                    for (int dd = 0; dd < 32; ++dd) wv[dd] = wp[(size_t)(d0 + dd) * 6144];
#pragma unroll
                    for (int dd = 0; dd < 32; ++dd) { const int d = 128 * wave + d0 + dd; a0 += wv[dd] * sc[d]; a1 += wv[dd] * sc[1024 + d]; a2 += wv[dd] * sc[2048 + d]; a3 += wv[dd] * sc[3072 + d]; } }
                LAS float* part = (LAS float*)(lds + 16384) + wave * 256;
                part[lane] = a0; part[64 + lane] = a1; part[128 + lane] = a2; part[192 + lane] = a3;
                __syncthreads();
                if (tid < 256) { float sum = b_ada[64 * cgi + (tid & 63)];
#pragma unroll
                    for (int w_ = 0; w_ < 8; ++w_) sum += ((LAS float*)(lds + 16384))[w_ * 256 + tid];
                    mod[(tid >> 6) * 6144 + 64 * cgi + (tid & 63)] = sum; }
                __syncthreads();
            }
            { LAS float* scr = (LAS float*)(lds + wave * 16384);
              constexpr int I_IN = 16 * 96, I_GATE = 16 * 64, I_BS = 8 * 32, I_OUT = 16 * 32, I_FF1 = 16 * 128, I_FF2 = 64 * 32;
              constexpr int NITEMS = I_IN + I_GATE + 2 * I_BS + I_OUT + I_FF1 + I_FF2;
              constexpr int NSLOT = 160 * 16 + 96 * 8;
              const int slot0 = gemv ? 2560 + bx * 8 + wave : (bx - 96) * 16 + wave * 2, nsl = gemv ? 1 : 2;
              if (G == 256) {
                for (int base = slot0; base < NITEMS; base += NSLOT)
                  for (int q_ = 0; q_ < nsl; ++q_) { int r = base + q_; if (r >= NITEMS) break;
                    if (r < I_IN) { transpose_item<1>(w_in, 1024, 3072, WCAT, scr, r, lane); continue; } r -= I_IN;
                    if (r < I_GATE) { transpose_item<2>(w_gate, 1024, 2048, WCAT, scr, r, lane); continue; } r -= I_GATE;
                    if (r < I_BS) { transpose_item<0>(w_bsb, 512, 1024, WBSB, scr, r, lane); continue; } r -= I_BS;
                    if (r < I_BS) { transpose_item<0>(w_bdf, 512, 1024, WBDF, scr, r, lane); continue; } r -= I_BS;
                    if (r < I_OUT) { transpose_item<0>(w_out, 1024, 1024, WOUT, scr, r, lane); continue; } r -= I_OUT;
                    if (r < I_FF1) { transpose_item<0>(w_ff1, 1024, 4096, WFF1, scr, r, lane); continue; } r -= I_FF1;
                    transpose_item<0>(w_ff2, 4096, 1024, WFF2, scr, r, lane); }
              } else {
                for (int it = gw; it < NITEMS; it += NGW) { int r = it;
                    if (r < I_IN) { transpose_item<1>(w_in, 1024, 3072, WCAT, scr, r, lane); continue; } r -= I_IN;
                    if (r < I_GATE) { transpose_item<2>(w_gate, 1024, 2048, WCAT, scr, r, lane); continue; } r -= I_GATE;
                    if (r < I_BS) { transpose_item<0>(w_bsb, 512, 1024, WBSB, scr, r, lane); continue; } r -= I_BS;
                    if (r < I_BS) { transpose_item<0>(w_bdf, 512, 1024, WBDF, scr, r, lane); continue; } r -= I_BS;
                    if (r < I_OUT) { transpose_item<0>(w_out, 1024, 1024, WOUT, scr, r, lane); continue; } r -= I_OUT;
                    if (r < I_FF1) { transpose_item<0>(w_ff1, 1024, 4096, WFF1, scr, r, lane); continue; } r -= I_FF1;
                    transpose_item<0>(w_ff2, 4096, 1024, WFF2, scr, r, lane); }
              } }
        } else if (ph == 1) {
            for (int m0 = gw * 8; m0 < M; m0 += NGW * 8) {
                const float* mb = mod + (m0 >> 12) * 6144;
                f32x4 ga[4], sh[4];
#pragma unroll
                for (int j = 0; j < 4; ++j) { const int col = 4 * lane + 256 * j; ga[j] = *(const f32x4*)(g_pre_mix + col) * (*(const f32x4*)(mb + 1024 + col) + 1.f); sh[j] = *(const f32x4*)(mb + col); }
                f32x4 nv[4];
#pragma unroll
                for (int j = 0; j < 4; ++j) nv[j] = ((const f32x4*)(x + (size_t)m0 * DM) + lane)[64 * j];
#pragma unroll 2
                for (int r = 0; r < 8; ++r) { const int m = m0 + r;
                    f32x4 v[4]; float s = 0.f;
#pragma unroll
                    for (int j = 0; j < 4; ++j) v[j] = nv[j];
                    if (r < 7) {
#pragma unroll
                        for (int j = 0; j < 4; ++j) nv[j] = ((const f32x4*)(x + (size_t)(m + 1) * DM) + lane)[64 * j]; }
#pragma unroll
                    for (int j = 0; j < 4; ++j) s += (v[j].x * v[j].x + v[j].y * v[j].y) + (v[j].z * v[j].z + v[j].w * v[j].w);
                    const float rstd = __builtin_amdgcn_rsqf(wave_sum(s) * (1.f / DM) + EPS);
                    u32x2* o8 = (u32x2*)(BUFA + (size_t)m * DM) + lane;
#pragma unroll
                    for (int j = 0; j < 4; ++j) { const f32x4 hv = v[j] * rstd * ga[j] + sh[j]; o8[64 * j] = (u32x2){cvtpk(hv.x, hv.y), cvtpk(hv.z, hv.w)}; }
                }
            }
        } else if (ph == 2) {
            static_assert((WS_WCAT + (size_t)4096 * 1024 * 2) + 44 * (size_t)(256 * 1024 * 2) == WS_BUFA && WS_WCAT + 60 * (size_t)(256 * 1024 * 2) == WS_BUFA, "V^T units address Wv / h as tiles of the h / W base pointers");
            if (G == 256) {
                pg8::Gemm g{BUFA, WCAT, M, 4096, 1024}; pg8::TwoOrder S; S.a.init(M, 4096, G, bx); S.b.init(1024, M, G, bx); S.na = 4; S.dpm = -44; S.dpn = 60;
                pg8::EpiProj E{QK, GATE, b_gate, pos, VT};
                pg8::gemm_phase<pg8::EpiProj, pg8::TwoOrder, true, true>(lds, g, S, E);
            } else {
            { pg8::Gemm g{BUFA, WCAT, M, 4096, 1024}; SO S; S.init(M, 4096, G, bx); pg8::EpiProj E{QK, GATE, b_gate, pos, VT};
              pg8::gemm_phase<pg8::EpiProj, SO, true, true>(lds, g, S, E); }
            { pg8::Gemm g{WCAT + (size_t)4096 * 1024, BUFA, 1024, M, 1024}; SO S; S.init(1024, M, G, bx); pg8::EpiPlain E{VT, M};
              pg8::gemm_phase<pg8::EpiPlain, SO, true, true>(lds, g, S, E); }
            }
        } else if (ph == 3) {
            float lam;
            { const float s1 = wave_sum(lq1[lane] * lk1[lane]), s2 = wave_sum(lq2[lane] * lk2[lane]); lam = __expf(s1) - __expf(s2) + LAMBDA_INIT; }
            volatile LAS unsigned* uword = (volatile LAS unsigned*)(lds + MISC_OFF);
            for (;;) {
                if (tid == 0) uword[0] = atomicAdd(queue + rep, 1u);
                __syncthreads();
                const unsigned idx = uword[0];
                __syncthreads();
                if (idx >= 1024u) break;
                if (idx < 256u || idx >= 768u) { const unsigned k = idx < 256u ? idx : idx - 512u; const int r2 = k & 15; att::attn_unit<true>(lds, QK, VT, BUFA, r2 >> 2, r2 & 3, 31 - (int)(k >> 4), lam, g_subln); }
                else { const int i2 = idx - 256, r2 = i2 & 15; att::attn_unit<false>(lds, QK, VT, BUFA, r2 >> 2, r2 & 3, 31 - (i2 >> 4), 0.f, g_subln); }
            }
        } else if (ph == 4) {
            static_assert(WS_WBDF == WS_WBSB + (size_t)1024 * 512 * 2, "branch weights adjacent");
            pg8::Gemm g{BUFA, WBSB, M, 1024, 512}; pg8::PairOrder S; S.a.init(M, 1024, G, bx); S.dpm = 64; S.dpn = 4;
            pg8::EpiGate E{MG, GATE};
            pg8::gemm_phase<pg8::EpiGate, pg8::PairOrder, true, true>(lds, g, S, E);
        } else if (ph == 5) {
            pg8::Gemm g{MG, WOUT, M, 1024, 1024}; SO S; S.init(M, 1024, G, bx);
            if (fused) { pg8::EpiMid E{x, MB, BUFA, mod, g_post_mix, g_pre_ffn, pg8::PanelX{rss1, pcnt}, pg8::PanelX{rss3, pcnt + 4096}};
                pg8::gemm_phase<pg8::EpiMid, SO, true, true>(lds, g, S, E); }
            else { pg8::EpiSumsq E{MB, 1024, rss1}; pg8::gemm_phase<pg8::EpiSumsq, SO, true, true>(lds, g, S, E); }
        } else if (ph == 6 && !fused) {
            f32x4 nx[4]; u32x2 nm[4]; float nrs = rss1[gw];
#pragma unroll
            for (int j = 0; j < 4; ++j) { nx[j] = ((const f32x4*)(x + (size_t)gw * DM) + lane)[64 * j]; nm[j] = ((const u32x2*)(MB + (size_t)gw * DM) + lane)[64 * j]; }
            for (int m = gw; m < M; m += NGW) {
                const float* mb = mod + (m >> 12) * 6144;
                const float rm = __builtin_amdgcn_rsqf(nrs * (1.f / DM) + EPS);
                f32x4* xo = (f32x4*)(out + (size_t)m * DM) + lane;
                f32x4 xv[4]; u32x2 mvv[4];
#pragma unroll
                for (int j = 0; j < 4; ++j) { xv[j] = nx[j]; mvv[j] = nm[j]; }
                if (m + NGW < M) { nrs = rss1[m + NGW];
#pragma unroll
                    for (int j = 0; j < 4; ++j) { nx[j] = ((const f32x4*)(x + (size_t)(m + NGW) * DM) + lane)[64 * j]; nm[j] = ((const u32x2*)(MB + (size_t)(m + NGW) * DM) + lane)[64 * j]; } }
                f32x4 v[4]; float s = 0.f;
#pragma unroll
                for (int j = 0; j < 4; ++j) { const int col = 4 * lane + 256 * j; const u32x2 mv = mvv[j];
                    const f32x4 mf = {bflo(mv.x), bfhi(mv.x), bflo(mv.y), bfhi(mv.y)};
                    const f32x4 g = *(const f32x4*)(g_post_mix + col), gt = *(const f32x4*)(mb + 2048 + col);
                    v[j] = xv[j] + gt * (mf * rm * g); xo[64 * j] = v[j];
                    s += (v[j].x * v[j].x + v[j].y * v[j].y) + (v[j].z * v[j].z + v[j].w * v[j].w); }
                const float rstd = __builtin_amdgcn_rsqf(wave_sum(s) * (1.f / DM) + EPS);
                u32x2* o8 = (u32x2*)(BUFA + (size_t)m * DM) + lane;
#pragma unroll
                for (int j = 0; j < 4; ++j) { const int col = 4 * lane + 256 * j;
                    const f32x4 g = *(const f32x4*)(g_pre_ffn + col), sh = *(const f32x4*)(mb + 3072 + col), sc = *(const f32x4*)(mb + 4096 + col);
                    const f32x4 hv = v[j] * rstd * g * (sc + 1.f) + sh;
                    o8[64 * j] = (u32x2){cvtpk(hv.x, hv.y), cvtpk(hv.z, hv.w)}; }
            }
        } else if (ph == 7) {
            pg8::Gemm g{BUFA, WFF1, M, FF, 1024}; SO S; S.init(M, FF, G, bx); pg8::EpiRelu2 E{FB, FF};
            pg8::gemm_phase<pg8::EpiRelu2, SO, true, true>(lds, g, S, E);
        } else if (ph == 8) {
            pg8::Gemm g{FB, WFF2, M, 1024, FF}; SO S; S.init(M, 1024, G, bx);
            if (fused) { pg8::EpiFinal E{out, MB, mod, g_post_ffn, pg8::PanelX{rss2, pcnt + 8192}}; pg8::gemm_phase<pg8::EpiFinal, SO, true, true>(lds, g, S, E); }
            else { pg8::EpiSumsq E{F2, 1024, rss2}; pg8::gemm_phase<pg8::EpiSumsq, SO, true, true>(lds, g, S, E); }
        } else if (ph == 9 && !fused) {
            f32x4 nx[4]; u32x2 nm[4]; float nrs = rss2[gw];
#pragma unroll
            for (int j = 0; j < 4; ++j) { nx[j] = ((const f32x4*)(out + (size_t)gw * DM) + lane)[64 * j]; nm[j] = ((const u32x2*)(F2 + (size_t)gw * DM) + lane)[64 * j]; }
            for (int m = gw; m < M; m += NGW) {
                const float* mb = mod + (m >> 12) * 6144;
                const float rm = __builtin_amdgcn_rsqf(nrs * (1.f / DM) + EPS);
                f32x4* xo = (f32x4*)(out + (size_t)m * DM) + lane;
                f32x4 xv[4]; u32x2 mvv[4];
#pragma unroll
                for (int j = 0; j < 4; ++j) { xv[j] = nx[j]; mvv[j] = nm[j]; }
                if (m + NGW < M) { nrs = rss2[m + NGW];
#pragma unroll
                    for (int j = 0; j < 4; ++j) { nx[j] = ((const f32x4*)(out + (size_t)(m + NGW) * DM) + lane)[64 * j]; nm[j] = ((const u32x2*)(F2 + (size_t)(m + NGW) * DM) + lane)[64 * j]; } }
#pragma unroll
                for (int j = 0; j < 4; ++j) { const int col = 4 * lane + 256 * j; const u32x2 mv = mvv[j];
                    const f32x4 mf = {bflo(mv.x), bfhi(mv.x), bflo(mv.y), bfhi(mv.y)};
                    const f32x4 g = *(const f32x4*)(g_post_ffn + col), gt = *(const f32x4*)(mb + 5120 + col);
                    xo[64 * j] = xv[j] + gt * (mf * rm * g); }
            }
        }
      }
        if (ph + 1 < hi_ph && !(fused && (ph == 5 || ph == 8))) GRID_BAR();
    }
}

#ifndef N_LAUNCH_PER_PHASE
#define N_LAUNCH_PER_PHASE 0
#endif

extern "C" void kernel_launch(void* const* d_in, const int* in_sizes, int n_in, void* d_out, int out_size, void* d_ws, size_t ws_size, hipStream_t stream) {
    static int grid = 0;
    if (grid == 0) {
        if (n_in != 22 || ws_size < WS_END) { fprintf(stderr, "kernel_launch: unexpected n_in %d / ws %zu\n", n_in, ws_size); grid = -1; return; }
        int dev = 0, cus = 0, per_cu = 0;
        hipGetDevice(&dev); hipDeviceGetAttribute(&cus, hipDeviceAttributeMultiprocessorCount, dev);
        hipFuncSetAttribute((const void*)fwd_kernel, hipFuncAttributeMaxDynamicSharedMemorySize, LDS_BYTES);
        hipOccupancyMaxActiveBlocksPerMultiprocessor(&per_cu, (const void*)fwd_kernel, NWAVES * 64, LDS_BYTES);
        if (per_cu < 1) per_cu = 1;
        grid = cus * per_cu;
        (void)hipGetLastError();
    }
    if (grid < 0) return;
    hipMemsetAsync((char*)d_ws + WS_CTL, 0, CTL_ZERO_BYTES, stream);
    Args a{};
    for (int i = 0; i < 22; ++i) a.in[i] = d_in[i];
    a.out = (float*)d_out; a.ws = (unsigned char*)d_ws;
#if N_LAUNCH_PER_PHASE
    for (int p = 0; p < NPHASE; ++p) {
        a.ph_lo = p; a.ph_hi = p + 1;
        void* kargs[] = {&a};
        hipError_t e = hipLaunchCooperativeKernel((const void*)fwd_kernel, dim3(grid), dim3(NWAVES * 64), kargs, LDS_BYTES, stream);
        if (e != hipSuccess) { fprintf(stderr, "cooperative launch failed: %s (grid %d)\n", hipGetErrorString(e), grid); break; }
    }
#else
    a.ph_lo = 0; a.ph_hi = NPHASE;
    void* kargs[] = {&a};
    hipError_t e = hipLaunchCooperativeKernel((const void*)fwd_kernel, dim3(grid), dim3(NWAVES * 64), kargs, LDS_BYTES, stream);
    if (e != hipSuccess) fprintf(stderr, "cooperative launch failed: %s (grid %d)\n", hipGetErrorString(e), grid);
#endif
}
```

```cpp
#include <hip/hip_runtime.h>
#include <hip/hip_cooperative_groups.h>
#include <cstdio>
#include <cstdint>
namespace cg = cooperative_groups;

#define LAS __attribute__((address_space(3)))
typedef unsigned short bf16_t;
typedef short bf16x8 __attribute__((ext_vector_type(8)));
typedef float f32x4 __attribute__((ext_vector_type(4)));
typedef float f32x16 __attribute__((ext_vector_type(16)));
typedef unsigned u32x4 __attribute__((ext_vector_type(4)));
typedef unsigned u32x2 __attribute__((ext_vector_type(2)));
typedef float f32x2_t __attribute__((ext_vector_type(2)));
typedef __bf16 bf16x2_t __attribute__((ext_vector_type(2)));

__device__ __forceinline__ unsigned cvtpk(float lo, float hi) { f32x2_t v = {lo, hi}; bf16x2_t b = __builtin_convertvector(v, bf16x2_t); return __builtin_bit_cast(unsigned, b); }
__device__ __forceinline__ float bflo(unsigned u) { return __uint_as_float(u << 16); }
__device__ __forceinline__ float bfhi(unsigned u) { return __uint_as_float(u & 0xffff0000u); }

constexpr int DM = 1024, SEQ = 4096, NB = 4, M = NB * SEQ, FF = 4096;
constexpr float EPS = 1e-6f;
constexpr float C2 = 0.125f * 1.4426950408889634f;
constexpr float LAMBDA_INIT = 0.2f;

constexpr size_t MiB = 1u << 20;
constexpr size_t WS_CTL = 0, CTL_ZERO_BYTES = 1 * MiB;
constexpr size_t CTL_MOD = 0;
constexpr size_t CTL_RSS1 = 128 * 1024;
constexpr size_t CTL_RSS2 = 192 * 1024;
constexpr size_t CTL_QUEUE = 256 * 1024;
constexpr size_t CTL_RSS3 = 320 * 1024;
constexpr size_t CTL_PCNT = 384 * 1024;
constexpr size_t CTL_BAR = 512 * 1024;
constexpr size_t WS_WCAT = 2 * MiB;
constexpr size_t WS_WBSB = 12 * MiB;
constexpr size_t WS_WBDF = 13 * MiB;
constexpr size_t WS_WOUT = 14 * MiB;
constexpr size_t WS_WFF1 = 16 * MiB;
constexpr size_t WS_WFF2 = 24 * MiB;
constexpr size_t WS_BUFA = 32 * MiB;
constexpr size_t WS_QK = 64 * MiB;
constexpr size_t WS_GATE = 128 * MiB;
constexpr size_t WS_F = 64 * MiB;
constexpr size_t WS_VT = 192 * MiB;
constexpr size_t WS_MG = 224 * MiB;
constexpr size_t WS_END = 256 * MiB;

namespace pg8 {
constexpr int BM = 256, BK = 64, HALF = 128, HTB = HALF * BK * 2, STAGE_BYTES = 8 * HTB, NXCD = 8, WGM = 8;
__host__ __device__ __forceinline__ int lds_byte(int r, int c) { const int st = (r >> 4) * 2 + (c >> 5), rr = r & 15, cc = c & 31, ob = rr * 64 + cc * 2; return st * 1024 + (ob ^ (((ob >> 9) & 1) << 5)); }
__host__ __device__ __forceinline__ void stage_rc(int b, int& R, int& C) { const int st = b / 1024, sb = b % 1024, swz = sb ^ (((sb >> 9) & 1) << 5); R = (st >> 1) * 16 + swz / 64; C = (st & 1) * 32 + (swz % 64) / 2; }
__host__ __device__ __forceinline__ int perm32(int rho) { const int n = rho >> 4, i = rho & 15; return 8 * (i >> 2) + 4 * n + (i & 3); }
struct Unit { int pm, pn; };
struct Gemm { const bf16_t* A; const bf16_t* Bt; int M, N, K; };
struct StaticOrder {
    int nM, nN, nwg, G, c;
    __host__ __device__ void init(int M_, int N_, int G_, int c_) { nM = M_ / BM; nN = N_ / BM; nwg = nM * nN; G = G_; c = c_; }
    __host__ __device__ bool next(int i, Unit& u) const {
        const long L = (long)i * G + c; if (L >= nwg) return false;
        int wgid = (int)L; { const int q = nwg / NXCD, r = nwg % NXCD, xcd = wgid % NXCD, off = wgid / NXCD; wgid = (xcd < r ? xcd * (q + 1) : r * (q + 1) + (xcd - r) * q) + off; }
        const int nig = WGM * nN, gid = wgid / nig, fm = gid * WGM, gsz = (nM - fm) < WGM ? (nM - fm) : WGM;
        u.pm = fm + ((wgid % nig) % gsz); u.pn = (wgid % nig) / gsz; return true;
    }
    __device__ __forceinline__ void a_ready(const Unit&) const {}
    __device__ __forceinline__ void done(const Unit&) const {}
};

struct TwoOrder {
    StaticOrder a, b; int na, dpm, dpn;
    __device__ __forceinline__ bool next(int i, Unit& u) const {
        if (i < na) return a.next(i, u);
        if (!b.next(i - na, u)) return false;
        u.pm += dpm; u.pn += dpn; return true;
    }
    __device__ __forceinline__ void a_ready(const Unit&) const {}
    __device__ __forceinline__ void done(const Unit&) const {}
};
struct PairOrder {
    StaticOrder a; int dpm, dpn;
    __device__ __forceinline__ bool next(int i, Unit& u) const { if (!a.next(i >> 1, u)) return false; if (i & 1) { u.pm += dpm; u.pn += dpn; } return true; }
    __device__ __forceinline__ void a_ready(const Unit&) const {}
    __device__ __forceinline__ void done(const Unit&) const {}
};

struct EpiPlain {
    static constexpr bool PERM = true, AFTER_DRAIN = false;
    bf16_t* O; int ldc;
    __device__ __forceinline__ void operator()(const f32x4 (&acc)[2][2][4][2], const Unit& u, int wr, int wc, int fr, int fq) const {
        const int row0 = u.pm * BM + wr * 64 + fr, col0 = u.pn * BM + wc * 32 + 8 * fq;
#pragma unroll
        for (int ai = 0; ai < 2; ++ai)
#pragma unroll
            for (int m = 0; m < 4; ++m) { bf16_t* rowp = O + (size_t)(row0 + ai * HALF + m * 16) * ldc + col0;
#pragma unroll
                for (int bj = 0; bj < 2; ++bj) { const f32x4 v0 = acc[ai][bj][m][0], v1 = acc[ai][bj][m][1];
                    u32x4 w; w.x = cvtpk(v0[0], v0[1]); w.y = cvtpk(v0[2], v0[3]); w.z = cvtpk(v1[0], v1[1]); w.w = cvtpk(v1[2], v1[3]);
                    *(u32x4*)(rowp + bj * HALF) = w; } }
    }
};
struct EpiRelu2 {
    static constexpr bool PERM = true, AFTER_DRAIN = false;
    bf16_t* O; int ldc;
    __device__ __forceinline__ void operator()(const f32x4 (&acc)[2][2][4][2], const Unit& u, int wr, int wc, int fr, int fq) const {
        const int row0 = u.pm * BM + wr * 64 + fr, col0 = u.pn * BM + wc * 32 + 8 * fq;
#pragma unroll
        for (int ai = 0; ai < 2; ++ai)
#pragma unroll
            for (int m = 0; m < 4; ++m) { bf16_t* rowp = O + (size_t)(row0 + ai * HALF + m * 16) * ldc + col0;
#pragma unroll
                for (int bj = 0; bj < 2; ++bj) { f32x4 v0 = acc[ai][bj][m][0], v1 = acc[ai][bj][m][1];
#pragma unroll
                    for (int k = 0; k < 4; ++k) { const float a = fmaxf(v0[k], 0.f), b = fmaxf(v1[k], 0.f); v0[k] = a * a; v1[k] = b * b; }
                    u32x4 w; w.x = cvtpk(v0[0], v0[1]); w.y = cvtpk(v0[2], v0[3]); w.z = cvtpk(v1[0], v1[1]); w.w = cvtpk(v1[2], v1[3]);
                    *(u32x4*)(rowp + bj * HALF) = w; } }
    }
};
struct EpiSumsq {
    static constexpr bool PERM = true, AFTER_DRAIN = false;
    bf16_t* O; int ldc; float* rss;
    __device__ __forceinline__ void operator()(const f32x4 (&acc)[2][2][4][2], const Unit& u, int wr, int wc, int fr, int fq) const {
        const int row0 = u.pm * BM + wr * 64 + fr, col0 = u.pn * BM + wc * 32 + 8 * fq;
#pragma unroll
        for (int ai = 0; ai < 2; ++ai)
#pragma unroll
            for (int m = 0; m < 4; ++m) { const int row = row0 + ai * HALF + m * 16; bf16_t* rowp = O + (size_t)row * ldc + col0; float s = 0.f;
#pragma unroll
                for (int bj = 0; bj < 2; ++bj) { const f32x4 v0 = acc[ai][bj][m][0], v1 = acc[ai][bj][m][1];
                    s += (v0[0] * v0[0] + v0[1] * v0[1]) + (v0[2] * v0[2] + v0[3] * v0[3]) + (v1[0] * v1[0] + v1[1] * v1[1]) + (v1[2] * v1[2] + v1[3] * v1[3]);
                    u32x4 w; w.x = cvtpk(v0[0], v0[1]); w.y = cvtpk(v0[2], v0[3]); w.z = cvtpk(v1[0], v1[1]); w.w = cvtpk(v1[2], v1[3]);
                    *(u32x4*)(rowp + bj * HALF) = w; }
                s += __shfl_xor(s, 16); s += __shfl_xor(s, 32);
                if (fq == 0) unsafeAtomicAdd(rss + row, s); }
    }
};
struct PanelX {
    float* rss; unsigned* cnt;
    __device__ __forceinline__ void run(const float (&part)[2][4], float (&tot)[2][4], const Unit& u, int wr, int fr, int fq) const {
        const int row0 = u.pm * BM + wr * 64 + fr;
#pragma unroll
        for (int ai = 0; ai < 2; ++ai)
#pragma unroll
            for (int m = 0; m < 4; ++m) { float s = part[ai][m]; s += __shfl_xor(s, 16); s += __shfl_xor(s, 32);
                if (fq == 0) __hip_atomic_fetch_add(rss + row0 + ai * HALF + m * 16, s, __ATOMIC_RELAXED, __HIP_MEMORY_SCOPE_AGENT); }
        asm volatile("s_waitcnt vmcnt(0)" ::: "memory");
        __builtin_amdgcn_s_barrier();
        if (threadIdx.x == 0) {
            unsigned* c = cnt + 64 * u.pm;
            __hip_atomic_fetch_add(c, 1u, __ATOMIC_RELEASE, __HIP_MEMORY_SCOPE_AGENT);
            unsigned sp = 0;
            while (__hip_atomic_load(c, __ATOMIC_RELAXED, __HIP_MEMORY_SCOPE_AGENT) < 4u) { __builtin_amdgcn_s_sleep(1); if (++sp > (1u << 22)) break; }
            __builtin_amdgcn_fence(__ATOMIC_ACQUIRE, "agent");
        }
        asm volatile("s_waitcnt vmcnt(0) lgkmcnt(0)" ::: "memory");
        __builtin_amdgcn_s_barrier();
#pragma unroll
        for (int ai = 0; ai < 2; ++ai)
#pragma unroll
            for (int m = 0; m < 4; ++m) tot[ai][m] = __hip_atomic_load(rss + row0 + ai * HALF + m * 16, __ATOMIC_RELAXED, __HIP_MEMORY_SCOPE_AGENT);
    }
};
struct EpiFinal {
    static constexpr bool PERM = true, AFTER_DRAIN = false;
    float* out; const bf16_t* X1B; const float* mod; const float* g_post; PanelX px;
    __device__ __forceinline__ void operator()(const f32x4 (&acc)[2][2][4][2], const Unit& u, int wr, int wc, int fr, int fq) const {
        const int row0 = u.pm * BM + wr * 64 + fr, col0 = u.pn * BM + wc * 32 + 8 * fq;
        float part[2][4], tot[2][4];
#pragma unroll
        for (int ai = 0; ai < 2; ++ai)
#pragma unroll
            for (int m = 0; m < 4; ++m) { float s = 0.f;
#pragma unroll
                for (int bj = 0; bj < 2; ++bj) { const f32x4 v0 = acc[ai][bj][m][0], v1 = acc[ai][bj][m][1];
                    s += (v0[0] * v0[0] + v0[1] * v0[1]) + (v0[2] * v0[2] + v0[3] * v0[3]) + (v1[0] * v1[0] + v1[1] * v1[1]) + (v1[2] * v1[2] + v1[3] * v1[3]); }
                part[ai][m] = s; }
        px.run(part, tot, u, wr, fr, fq);
        const float* gtp = mod + ((u.pm * BM) >> 12) * 6144 + 5120 + col0;
#pragma unroll
        for (int bj = 0; bj < 2; ++bj) { f32x4 gg[2];
#pragma unroll
            for (int n = 0; n < 2; ++n) gg[n] = *(const f32x4*)(gtp + bj * HALF + 4 * n) * *(const f32x4*)(g_post + col0 + bj * HALF + 4 * n);
#pragma unroll
            for (int ai = 0; ai < 2; ++ai)
#pragma unroll
                for (int m = 0; m < 4; ++m) { const float rstd = __builtin_amdgcn_rsqf(tot[ai][m] * (1.f / 1024.f) + 1e-6f);
                    const size_t off = (size_t)(row0 + ai * HALF + m * 16) * 1024 + col0 + bj * HALF; float* op = out + off;
                    const u32x4 xb = *(const u32x4*)(X1B + off);
                    const f32x4 x0 = {bflo(xb.x), bfhi(xb.x), bflo(xb.y), bfhi(xb.y)}, x1v = {bflo(xb.z), bfhi(xb.z), bflo(xb.w), bfhi(xb.w)};
                    *(f32x4*)(op) = x0 + gg[0] * (acc[ai][bj][m][0] * rstd); *(f32x4*)(op + 4) = x1v + gg[1] * (acc[ai][bj][m][1] * rstd);
                    if (m & 1) asm volatile("" ::: "memory"); } }
    }
};
struct EpiMid {
    static constexpr bool PERM = true, AFTER_DRAIN = false;
    const float* x; bf16_t* X1B; bf16_t* H2; const float* mod; const float* g_post; const float* g_pre; PanelX px1, px2;
    __device__ __forceinline__ void operator()(f32x4 (&acc)[2][2][4][2], const Unit& u, int wr, int wc, int fr, int fq) const {
        const int row0 = u.pm * BM + wr * 64 + fr, col0 = u.pn * BM + wc * 32 + 8 * fq;
        float part[2][4], tot[2][4];
#pragma unroll
        for (int ai = 0; ai < 2; ++ai)
#pragma unroll
            for (int m = 0; m < 4; ++m) { float s = 0.f;
#pragma unroll
                for (int bj = 0; bj < 2; ++bj) { const f32x4 v0 = acc[ai][bj][m][0], v1 = acc[ai][bj][m][1];
                    s += (v0[0] * v0[0] + v0[1] * v0[1]) + (v0[2] * v0[2] + v0[3] * v0[3]) + (v1[0] * v1[0] + v1[1] * v1[1]) + (v1[2] * v1[2] + v1[3] * v1[3]); }
                part[ai][m] = s; }
        px1.run(part, tot, u, wr, fr, fq);
        const float* mb = mod + ((u.pm * BM) >> 12) * 6144;
#pragma unroll
        for (int ai = 0; ai < 2; ++ai)
#pragma unroll
            for (int m = 0; m < 4; ++m) part[ai][m] = 0.f;
#pragma unroll
        for (int bj = 0; bj < 2; ++bj) { f32x4 gg[2];
#pragma unroll
            for (int n = 0; n < 2; ++n) gg[n] = *(const f32x4*)(mb + 2048 + col0 + bj * HALF + 4 * n) * *(const f32x4*)(g_post + col0 + bj * HALF + 4 * n);
#pragma unroll
            for (int ai = 0; ai < 2; ++ai)
#pragma unroll
                for (int m = 0; m < 4; ++m) { const float rstd = __builtin_amdgcn_rsqf(tot[ai][m] * (1.f / 1024.f) + 1e-6f);
                    const size_t off = (size_t)(row0 + ai * HALF + m * 16) * 1024 + col0 + bj * HALF;
#pragma unroll
                    for (int n = 0; n < 2; ++n) { const f32x4 v = *(const f32x4*)(x + off + 4 * n) + gg[n] * (acc[ai][bj][m][n] * rstd); acc[ai][bj][m][n] = v;
                        part[ai][m] += (v[0] * v[0] + v[1] * v[1]) + (v[2] * v[2] + v[3] * v[3]); }
                    { const f32x4 v0 = acc[ai][bj][m][0], v1 = acc[ai][bj][m][1]; u32x4 w; w.x = cvtpk(v0[0], v0[1]); w.y = cvtpk(v0[2], v0[3]); w.z = cvtpk(v1[0], v1[1]); w.w = cvtpk(v1[2], v1[3]); *(u32x4*)(X1B + off) = w; }
                    if (m & 1) asm volatile("" ::: "memory"); } }
        px2.run(part, tot, u, wr, fr, fq);
#pragma unroll
        for (int bj = 0; bj < 2; ++bj) { f32x4 gg[2], sh[2];
#pragma unroll
            for (int n = 0; n < 2; ++n) { gg[n] = (*(const f32x4*)(mb + 4096 + col0 + bj * HALF + 4 * n) + 1.f) * *(const f32x4*)(g_pre + col0 + bj * HALF + 4 * n); sh[n] = *(const f32x4*)(mb + 3072 + col0 + bj * HALF + 4 * n); }
#pragma unroll
            for (int ai = 0; ai < 2; ++ai)
#pragma unroll
                for (int m = 0; m < 4; ++m) { const float rstd = __builtin_amdgcn_rsqf(tot[ai][m] * (1.f / 1024.f) + 1e-6f);
                    const f32x4 h0 = acc[ai][bj][m][0] * rstd * gg[0] + sh[0], h1 = acc[ai][bj][m][1] * rstd * gg[1] + sh[1];
                    u32x4 w; w.x = cvtpk(h0[0], h0[1]); w.y = cvtpk(h0[2], h0[3]); w.z = cvtpk(h1[0], h1[1]); w.w = cvtpk(h1[2], h1[3]);
                    *(u32x4*)(H2 + (size_t)(row0 + ai * HALF + m * 16) * 1024 + col0 + bj * HALF) = w; } }
    }
};
struct EpiGate {
    static constexpr bool PERM = true, AFTER_DRAIN = false;
    bf16_t* O; const bf16_t* G;
    __device__ __forceinline__ void operator()(f32x4 (&acc)[2][2][4][2], const Unit& u, int wr, int wc, int fr, int fq) const {
        const bool second = u.pm >= 64;
        const int row0 = (u.pm & 63) * BM + wr * 64 + fr, col0 = (u.pn & 3) * BM + wc * 32 + 8 * fq;
#pragma unroll
        for (int ai = 0; ai < 2; ++ai)
#pragma unroll
            for (int m = 0; m < 4; ++m) { const int row = row0 + ai * HALF + m * 16; bf16_t* rowp = O + (size_t)row * 1024 + col0; const bf16_t* gp = G + (size_t)row * 2048 + col0;
#pragma unroll
                for (int bj = 0; bj < 2; ++bj) {
                    const u32x4 d = *(const u32x4*)(gp + 1024 + bj * HALF);
                    f32x4 g0, g1;
                    g0[0] = fmaxf(bflo(d.x), 1e-30f); g0[1] = fmaxf(bfhi(d.x), 1e-30f); g0[2] = fmaxf(bflo(d.y), 1e-30f); g0[3] = fmaxf(bfhi(d.y), 1e-30f);
                    g1[0] = fmaxf(bflo(d.z), 1e-30f); g1[1] = fmaxf(bfhi(d.z), 1e-30f); g1[2] = fmaxf(bflo(d.w), 1e-30f); g1[3] = fmaxf(bfhi(d.w), 1e-30f);
                    if (second) { const f32x4 v0 = acc[ai][bj][m][0] * g0, v1 = acc[ai][bj][m][1] * g1;
                        u32x4 w; w.x = cvtpk(v0[0], v0[1]); w.y = cvtpk(v0[2], v0[3]); w.z = cvtpk(v1[0], v1[1]); w.w = cvtpk(v1[2], v1[3]);
                        *(u32x4*)(rowp + bj * HALF) = w; }
                    else { const u32x4 a = *(const u32x4*)(gp + bj * HALF);
                        f32x4 r0, r1;
                        r0[0] = bflo(a.x) * __builtin_amdgcn_rcpf(g0[0]); r0[1] = bfhi(a.x) * __builtin_amdgcn_rcpf(g0[1]); r0[2] = bflo(a.y) * __builtin_amdgcn_rcpf(g0[2]); r0[3] = bfhi(a.y) * __builtin_amdgcn_rcpf(g0[3]);
                        r1[0] = bflo(a.z) * __builtin_amdgcn_rcpf(g1[0]); r1[1] = bfhi(a.z) * __builtin_amdgcn_rcpf(g1[1]); r1[2] = bflo(a.w) * __builtin_amdgcn_rcpf(g1[2]); r1[3] = bfhi(a.w) * __builtin_amdgcn_rcpf(g1[3]);
                        acc[ai][bj][m][0] *= r0; acc[ai][bj][m][1] *= r1; } }
                if (m & 1) asm volatile("" ::: "memory"); }
    }
};
struct EpiProj {
    static constexpr bool PERM = true, AFTER_DRAIN = false;
    bf16_t* QK; bf16_t* G; const float* b_gate; const int* pos; bf16_t* VT;
    __device__ __forceinline__ void operator()(const f32x4 (&acc)[2][2][4][2], const Unit& u, int wr, int wc, int fr, int fq) const {
        if (u.pm < 0) {
            const int vr0 = (u.pm + 44) * BM + wr * 64 + fr, vc0 = (u.pn - 60) * BM + wc * 32 + 8 * fq;
#pragma unroll
            for (int ai = 0; ai < 2; ++ai)
#pragma unroll
                for (int m = 0; m < 4; ++m) { bf16_t* rowp = VT + (size_t)(vr0 + ai * HALF + m * 16) * 16384 + vc0;
#pragma unroll
                    for (int bj = 0; bj < 2; ++bj) { const f32x4 v0 = acc[ai][bj][m][0], v1 = acc[ai][bj][m][1];
                        u32x4 w; w.x = cvtpk(v0[0], v0[1]); w.y = cvtpk(v0[2], v0[3]); w.z = cvtpk(v1[0], v1[1]); w.w = cvtpk(v1[2], v1[3]);
                        *(u32x4*)(rowp + bj * HALF) = w; } }
            return;
        }
        const int row0 = u.pm * BM + wr * 64 + fr, colt = u.pn * BM, cl = wc * 32 + 8 * fq;
        if (colt >= 2048) {
            const int gc = colt - 2048 + cl;
            f32x4 bv[2][2];
#pragma unroll
            for (int bj = 0; bj < 2; ++bj)
#pragma unroll
                for (int n = 0; n < 2; ++n) bv[bj][n] = *(const f32x4*)(b_gate + gc + bj * HALF + 4 * n);
#pragma unroll
            for (int ai = 0; ai < 2; ++ai)
#pragma unroll
                for (int m = 0; m < 4; ++m) { bf16_t* rowp = G + (size_t)(row0 + ai * HALF + m * 16) * 2048 + gc;
#pragma unroll
                    for (int bj = 0; bj < 2; ++bj) { f32x4 v0 = acc[ai][bj][m][0] + bv[bj][0], v1 = acc[ai][bj][m][1] + bv[bj][1];
#pragma unroll
                        for (int k = 0; k < 4; ++k) { v0[k] = __builtin_amdgcn_rcpf(1.f + __expf(-v0[k])); v1[k] = __builtin_amdgcn_rcpf(1.f + __expf(-v1[k])); }
                        u32x4 w; w.x = cvtpk(v0[0], v0[1]); w.y = cvtpk(v0[2], v0[3]); w.z = cvtpk(v1[0], v1[1]); w.w = cvtpk(v1[2], v1[3]);
                        *(u32x4*)(rowp + bj * HALF) = w; } }
        } else if (colt >= 1024) {
            const float sc = (colt < 1536) ? C2 : 1.f;
            const int i0 = 16 * (wc & 1) + 4 * fq;
            float inv[4];
#pragma unroll
            for (int j = 0; j < 4; ++j) inv[j] = __builtin_amdgcn_exp2f(-(float)(i0 + j) * 0.41524101186092029f);
#pragma unroll
            for (int ai = 0; ai < 2; ++ai)
#pragma unroll
                for (int m = 0; m < 4; ++m) { const int row = row0 + ai * HALF + m * 16; const float p = (float)pos[row]; bf16_t* rowp = QK + (size_t)row * 2048 + colt + cl;
                    float cs[4], sn[4];
#pragma unroll
                    for (int j = 0; j < 4; ++j) { const float ang = p * inv[j]; const float k = rintf(ang * 0.15915494309189535f);
                        float r = fmaf(-k, 6.28125f, ang); r = fmaf(-k, 1.9353071795864769e-3f, r); cs[j] = __cosf(r) * sc; sn[j] = __sinf(r) * sc; }
#pragma unroll
                    for (int bj = 0; bj < 2; ++bj) { const f32x4 v0 = acc[ai][bj][m][0], v1 = acc[ai][bj][m][1];
                        u32x4 w;
                        w.x = cvtpk(v0[0] * cs[0] - v0[1] * sn[0], v0[0] * sn[0] + v0[1] * cs[0]);
                        w.y = cvtpk(v0[2] * cs[1] - v0[3] * sn[1], v0[2] * sn[1] + v0[3] * cs[1]);
                        w.z = cvtpk(v1[0] * cs[2] - v1[1] * sn[2], v1[0] * sn[2] + v1[1] * cs[2]);
                        w.w = cvtpk(v1[2] * cs[3] - v1[3] * sn[3], v1[2] * sn[3] + v1[3] * cs[3]);
                        *(u32x4*)(rowp + bj * HALF) = w; } }
        } else {
            const float sc = (colt < 512) ? C2 : 1.f;
#pragma unroll
            for (int ai = 0; ai < 2; ++ai)
#pragma unroll
                for (int m = 0; m < 4; ++m) { bf16_t* rowp = QK + (size_t)(row0 + ai * HALF + m * 16) * 2048 + colt + cl;
#pragma unroll
                    for (int bj = 0; bj < 2; ++bj) { const f32x4 v0 = acc[ai][bj][m][0] * sc, v1 = acc[ai][bj][m][1] * sc;
                        u32x4 w; w.x = cvtpk(v0[0], v0[1]); w.y = cvtpk(v0[2], v0[3]); w.z = cvtpk(v1[0], v1[1]); w.w = cvtpk(v1[2], v1[3]);
                        *(u32x4*)(rowp + bj * HALF) = w; } }
        }
    }
};

template <class E> struct EpiKeep { static __device__ __forceinline__ bool keep(const Unit&) { return false; } };
struct EpiGate;
template <> struct EpiKeep<EpiGate> { static __device__ __forceinline__ bool keep(const Unit& u) { return u.pm < 64; } };
template <class Epi, class Sched, bool ALIGN_EPI = false, bool SP2 = false>
__device__ __forceinline__ void gemm_phase(LAS unsigned char* lds, const Gemm g, const Sched& S, const Epi& E) {
    int tid = threadIdx.x; asm volatile("" : "+v"(tid));
    const int wid = __builtin_amdgcn_readfirstlane(tid >> 6), lane = tid & 63, wr = wid >> 2, wc = wid & 3, fr = lane & 15, fq = lane >> 4;
    const int K = g.K, nt = K / BK;
    unsigned voffA[2], voffB[2];
#pragma unroll
    for (int i = 0; i < 2; ++i) { int R, C; stage_rc(tid * 16 + i * 8192, R, C); const int Rb = Epi::PERM ? ((R & ~31) + perm32(R & 31)) : R;
        voffA[i] = (unsigned)(R * K + C) * 2u; voffB[i] = (unsigned)(Rb * K + C) * 2u; }
    const size_t kstep = (size_t)(BK * 2);
    const size_t hstep = (size_t)HALF * K * 2;
    const size_t tstep = 2 * hstep;
    const unsigned ldsw = (unsigned)wid * 1024u;
    const int aoff = lds_byte(wr * 64 + fr, fq * 8), boff = lds_byte(wc * 32 + fr, fq * 8);
#define PG8_SA(b, h) (((b) * 2 + (h)) * HTB)
#define PG8_SB(b, h) ((4 + (b) * 2 + (h)) * HTB)
#define PG8_STAGE(bufoff, gbase, voff) do { _Pragma("unroll") for (int _i = 0; _i < 2; ++_i) \
        __builtin_amdgcn_global_load_lds((const unsigned*)((const char*)(gbase) + (voff)[_i]), (LAS unsigned*)(lds + (bufoff) + ldsw + _i * 8192), 16, 0, 0); } while (0)
#define PG8_LDA(dst, b, h) do { _Pragma("unroll") for (int m = 0; m < 4; ++m) _Pragma("unroll") for (int k = 0; k < 2; ++k) dst[m][k] = *(const LAS bf16x8*)(lds + PG8_SA(b, h) + aoff + m * 2048 + k * 1024); } while (0)
#define PG8_LDB(dst, b, h) do { _Pragma("unroll") for (int n = 0; n < 2; ++n) _Pragma("unroll") for (int k = 0; k < 2; ++k) dst[n][k] = *(const LAS bf16x8*)(lds + PG8_SB(b, h) + boff + n * 2048 + k * 1024); } while (0)
#define PG8_MMA(ai, bj, At, Bt) do { __builtin_amdgcn_s_setprio(1); _Pragma("unroll") for (int m = 0; m < 4; ++m) _Pragma("unroll") for (int n = 0; n < 2; ++n) _Pragma("unroll") for (int k = 0; k < 2; ++k) \
        acc[ai][bj][m][n] = __builtin_amdgcn_mfma_f32_16x16x32_bf16(Bt[n][k], At[m][k], acc[ai][bj][m][n], 0, 0, 0); __builtin_amdgcn_s_setprio(0); } while (0)
#define PG8_WAIT_V(n) asm volatile("s_waitcnt vmcnt(" #n ")" ::: "memory")
#define PG8_WAIT_L(n) asm volatile("s_waitcnt lgkmcnt(" #n ")" ::: "memory")
#define PG8_BAR __builtin_amdgcn_s_barrier()
#define PG8_SCHED __builtin_amdgcn_sched_barrier(0)
    Unit cur, nxt; int ui = 0;
    if (!S.next(0, cur)) return;
    f32x4 acc[2][2][4][2];
#pragma unroll
    for (int a = 0; a < 2; ++a)
#pragma unroll
        for (int b = 0; b < 2; ++b)
#pragma unroll
            for (int m = 0; m < 4; ++m)
#pragma unroll
                for (int n = 0; n < 2; ++n) acc[a][b][m][n] = (f32x4){0.f, 0.f, 0.f, 0.f};
    bf16x8 At[4][2], B0[2][2], B1[2][2];
    const char* cA = (const char*)g.A + (size_t)cur.pm * tstep; const char* cB = (const char*)g.Bt + (size_t)cur.pn * tstep;
    S.a_ready(cur);
    if constexpr (SP2) {
        PG8_STAGE(PG8_SB(0, 0), cB, voffB); PG8_STAGE(PG8_SB(0, 1), cB + hstep, voffB); PG8_STAGE(PG8_SA(0, 0), cA, voffA); PG8_STAGE(PG8_SA(0, 1), cA + hstep, voffA);
        if (wr == 1) PG8_BAR;
        PG8_WAIT_V(2); PG8_BAR;
        PG8_STAGE(PG8_SB(1, 0), cB + kstep, voffB); PG8_STAGE(PG8_SA(1, 0), cA + kstep, voffA); PG8_STAGE(PG8_SB(1, 1), cB + hstep + kstep, voffB);
        PG8_WAIT_V(6); PG8_BAR;
    } else {
        PG8_STAGE(PG8_SB(0, 0), cB, voffB); PG8_STAGE(PG8_SA(0, 0), cA, voffA); PG8_STAGE(PG8_SB(0, 1), cB + hstep, voffB); PG8_STAGE(PG8_SA(0, 1), cA + hstep, voffA);
        if (wr == 1) PG8_BAR;
        PG8_WAIT_V(4); PG8_BAR;
        PG8_STAGE(PG8_SB(1, 0), cB + kstep, voffB); PG8_STAGE(PG8_SA(1, 0), cA + kstep, voffA); PG8_STAGE(PG8_SB(1, 1), cB + hstep + kstep, voffB);
        PG8_WAIT_V(6); PG8_BAR;
    }
    for (;;) {
        const bool has_next = S.next(ui + 1, nxt);
        const char* nA = has_next ? (const char*)g.A + (size_t)nxt.pm * tstep : cA; const char* nB = has_next ? (const char*)g.Bt + (size_t)nxt.pn * tstep : cB;
        for (int t = 0; t < nt; t += 2) {
            const bool last = (t == nt - 2);
            const char* a1 = cA + (size_t)(t + 1) * kstep;
            const char* a2 = last ? nA : cA + (size_t)(t + 2) * kstep; const char* b2 = last ? nB : cB + (size_t)(t + 2) * kstep;
            const char* a3 = a2 + kstep; const char* b3 = b2 + kstep;
            if (last && has_next) S.a_ready(nxt);
            if constexpr (SP2) {
            PG8_LDB(B0, 0, 0); PG8_LDB(B1, 0, 1); PG8_SCHED; PG8_LDA(At, 0, 0); PG8_STAGE(PG8_SA(1, 1), a1 + hstep, voffA);
            PG8_WAIT_V(8); PG8_WAIT_L(0); PG8_BAR; PG8_MMA(0, 0, At, B0); PG8_MMA(0, 1, At, B1); PG8_BAR; PG8_SCHED;
            PG8_LDA(At, 0, 1); PG8_STAGE(PG8_SB(0, 0), b2, voffB); PG8_STAGE(PG8_SB(0, 1), b2 + hstep, voffB); PG8_STAGE(PG8_SA(0, 0), a2, voffA);
            PG8_WAIT_V(8); PG8_WAIT_L(0); PG8_BAR; PG8_MMA(1, 0, At, B0); PG8_MMA(1, 1, At, B1); PG8_BAR; PG8_SCHED;
            PG8_LDB(B0, 1, 0); PG8_LDB(B1, 1, 1); PG8_SCHED; PG8_LDA(At, 1, 0); PG8_STAGE(PG8_SA(0, 1), a2 + hstep, voffA);
            PG8_WAIT_V(8); PG8_WAIT_L(0); PG8_BAR; PG8_MMA(0, 0, At, B0); PG8_MMA(0, 1, At, B1); PG8_BAR; PG8_SCHED;
            PG8_LDA(At, 1, 1); PG8_STAGE(PG8_SB(1, 0), b3, voffB); PG8_STAGE(PG8_SB(1, 1), b3 + hstep, voffB); PG8_STAGE(PG8_SA(1, 0), a3, voffA);
            PG8_WAIT_V(8); PG8_WAIT_L(0); PG8_BAR; PG8_MMA(1, 0, At, B0); PG8_MMA(1, 1, At, B1); PG8_BAR; PG8_SCHED;
            } else {
            PG8_LDB(B0, 0, 0); PG8_SCHED; PG8_LDA(At, 0, 0); PG8_STAGE(PG8_SA(1, 1), a1 + hstep, voffA);
            PG8_WAIT_L(8); PG8_BAR; PG8_WAIT_L(0); PG8_MMA(0, 0, At, B0); PG8_BAR; PG8_SCHED;
            PG8_LDB(B1, 0, 1); PG8_STAGE(PG8_SB(0, 0), b2, voffB);
            PG8_BAR; PG8_WAIT_L(0); PG8_MMA(0, 1, At, B1); PG8_BAR;
            PG8_LDA(At, 0, 1); PG8_STAGE(PG8_SA(0, 0), a2, voffA);
            PG8_BAR; PG8_WAIT_L(0); PG8_MMA(1, 0, At, B0); PG8_BAR; PG8_SCHED;
            PG8_STAGE(PG8_SB(0, 1), b2 + hstep, voffB);
            PG8_WAIT_V(6); PG8_BAR; PG8_MMA(1, 1, At, B1); PG8_BAR;
            PG8_LDB(B0, 1, 0); PG8_SCHED; PG8_LDA(At, 1, 0); PG8_STAGE(PG8_SA(0, 1), a2 + hstep, voffA);
            PG8_WAIT_L(8); PG8_BAR; PG8_WAIT_L(0); PG8_MMA(0, 0, At, B0); PG8_BAR; PG8_SCHED;
            PG8_LDB(B1, 1, 1); PG8_STAGE(PG8_SB(1, 0), b3, voffB);
            PG8_BAR; PG8_WAIT_L(0); PG8_MMA(0, 1, At, B1); PG8_BAR;
            PG8_LDA(At, 1, 1); PG8_STAGE(PG8_SA(1, 0), a3, voffA);
            PG8_BAR; PG8_WAIT_L(0); PG8_MMA(1, 0, At, B0); PG8_BAR; PG8_SCHED;
            PG8_STAGE(PG8_SB(1, 1), b3 + hstep, voffB);
            PG8_WAIT_V(6); PG8_BAR; PG8_MMA(1, 1, At, B1); PG8_BAR;
            }
        }
        if constexpr (ALIGN_EPI) { if (wr == 0) PG8_BAR; }
        if constexpr (!Epi::AFTER_DRAIN) { E(acc, cur, wr, wc, fr, fq); S.done(cur); }
        if (!has_next) break;
        if (!EpiKeep<Epi>::keep(cur)) {
#pragma unroll
        for (int a = 0; a < 2; ++a)
#pragma unroll
            for (int b = 0; b < 2; ++b)
#pragma unroll
                for (int m = 0; m < 4; ++m)
#pragma unroll
                    for (int n = 0; n < 2; ++n) acc[a][b][m][n] = (f32x4){0.f, 0.f, 0.f, 0.f};
        }
        cur = nxt; cA = nA; cB = nB; ++ui;
        if constexpr (ALIGN_EPI) { if (wr == 1) PG8_BAR; }
    }
    PG8_WAIT_V(0);
    if constexpr (!ALIGN_EPI) { if (wr == 0) PG8_BAR; }
    PG8_BAR;
#undef PG8_SA
#undef PG8_SB
#undef PG8_STAGE
#undef PG8_LDA
#undef PG8_LDB
#undef PG8_MMA
#undef PG8_WAIT_V
#undef PG8_WAIT_L
#undef PG8_BAR
#undef PG8_SCHED
}
}

namespace att {
constexpr int KROW = 144, VROW = 144, BUF = 36864, K2OFF = 9216, VOFF = 18432;
constexpr int QKP = 2048;
constexpr float SB_EXIT = 1.0e-38f;

__device__ __forceinline__ float partner(float v) {
    const unsigned own = __float_as_uint(v);
    auto rr = __builtin_amdgcn_permlane32_swap(own, own, false, false);
    const unsigned a = rr[0], b = rr[1];
    return __uint_as_float(a == own ? b : a);
}
__device__ __forceinline__ bf16x8 pack8(float a0, float a1, float a2, float a3, float a4, float a5, float a6, float a7) {
    u32x4 w; w.x = cvtpk(a0, a1); w.y = cvtpk(a2, a3); w.z = cvtpk(a4, a5); w.w = cvtpk(a6, a7); return __builtin_bit_cast(bf16x8, w);
}
#define MFMA32(a, b, c) __builtin_amdgcn_mfma_f32_32x32x16_bf16((a), (b), (c), 0, 0, 0)
__device__ __forceinline__ float max3f(float a, float b, float c) { float r; asm("v_max3_f32 %0, %1, %2, %3" : "=v"(r) : "v"(a), "v"(b), "v"(c)); return r; }
constexpr float DF_THR = 8.f;

constexpr int KBUF = 18432, VOFF0 = 2 * KBUF, VBUF = 128 * VROW, FLAGS_OFF = VOFF0 + 3 * VBUF;
template <bool DF>
__device__ __forceinline__ void attn_unit(LAS unsigned char* lds, const bf16_t* __restrict__ QK, const bf16_t* __restrict__ VT, bf16_t* __restrict__ Y,
                                          int b, int h, int qb, float lam, const float* __restrict__ g_subln) {
    int tid = threadIdx.x; asm volatile("" : "+v"(tid));
    const int lane = tid & 63, wid = __builtin_amdgcn_readfirstlane(tid >> 6), r32 = lane & 31, hi = lane >> 5;
    const int sub = wid >> 2, wq = wid & 3;
    const int t0 = qb * 128 + wq * 32;
    const size_t tokbase = (size_t)b * SEQ;
    const int qcol = (DF ? 1024 : 0) + (2 * h + sub) * 64;
    const int kcol = (DF ? 1536 : 512) + h * 128;
    const int vrow0 = (DF ? 512 : 0) + h * 128;
    constexpr int NC = 2;
    constexpr int ND = DF ? 4 : 2;
    const int jt = 2 * qb + 1, jd = t0 >> 6;

    const bf16_t* ksrc[NC]; const bf16_t* vsrc[NC]; unsigned kdst[NC], vdst[NC];
#pragma unroll
    for (int i = 0; i < NC; ++i) {
        const int cid = tid + 512 * i;
        { const int key = cid >> 4, c = cid & 15; ksrc[i] = QK + (tokbase + key) * QKP + kcol + 8 * c; kdst[i] = (unsigned)((c >> 3) * K2OFF + key * KROW + (c & 7) * 16); }
        const int d = cid >> 3, c = cid & 7; vsrc[i] = VT + (size_t)(vrow0 + d) * M + tokbase + 8 * c; vdst[i] = (unsigned)(VOFF0 + d * VROW + (c >> 1) * 32 + (c & 1) * 8);
    }
    u32x4 kA[NC], vA[NC], kB[NC], vB[NC];
#define ATT_GLOAD(KS, VS, j) do { _Pragma("unroll") for (int i_ = 0; i_ < NC; ++i_) { KS[i_] = *(const u32x4*)(ksrc[i_] + (size_t)(j) * 64 * QKP); VS[i_] = *(const u32x4*)(vsrc[i_] + (j) * 64); } } while (0)
#define ATT_LSTORE(kbo, vbo, KS, VS) do { _Pragma("unroll") for (int i_ = 0; i_ < NC; ++i_) { *(LAS u32x4*)(lds + (kbo) + kdst[i_]) = KS[i_]; \
        *(LAS u32x2*)(lds + (vbo) + vdst[i_]) = (u32x2){VS[i_].x, VS[i_].y}; *(LAS u32x2*)(lds + (vbo) + vdst[i_] + 16) = (u32x2){VS[i_].z, VS[i_].w}; } } while (0)
#define ATT_VFRAG(dst, vbase, dd0) do { _Pragma("unroll") for (int i_ = 0; i_ < 8; ++i_) dst[i_] = *(const LAS bf16x8*)((vbase) + ((dd0) + (i_ >> 2)) * 32 * VROW + (i_ & 3) * 32); } while (0)

    bf16x8 qf[4];
    { const bf16_t* Qp = QK + (tokbase + t0 + r32) * QKP + qcol + hi * 8;
#pragma unroll
      for (int d0 = 0; d0 < 4; ++d0) qf[d0] = *(const bf16x8*)(Qp + d0 * 16); }
    ATT_GLOAD(kA, vA, jt);
    ATT_GLOAD(kB, vB, jt - 1);
    f32x16 o[ND];
#pragma unroll
    for (int dd = 0; dd < ND; ++dd) o[dd] = f32x16{};
    float carry = DF ? 0.f : 1.f;
    float lsum = 0.f;
    f32x16 negm = f32x16{};
    bool first = true;
    ATT_LSTORE(0, 0, kA, vA);
#pragma unroll
    for (int d0 = 0; d0 < 4; ++d0) asm volatile("" : "+v"(qf[d0]));
    ATT_GLOAD(kA, vA, (jt >= 2 ? jt - 2 : 0));
    __syncthreads();

    if (wid >= 4) __builtin_amdgcn_s_setprio(1);
    bool done = false;
    volatile LAS unsigned* flags = (volatile LAS unsigned*)(lds + FLAGS_OFF);
    bf16x8 pk[4];
#pragma unroll
    for (int ks = 0; ks < 4; ++ks) pk[ks] = bf16x8{};
    int vcur = 0, vprev = 0;
    auto step = [&](const int j, const int kcur, u32x4 (&KS)[NC], u32x4 (&VS)[NC]) -> bool {
        const int vnext = (vcur == 2 * VBUF) ? 0 : vcur + VBUF;
        if (j <= jd && !done) {
            const LAS unsigned char* Kb = lds + kcur + sub * K2OFF + r32 * KROW + hi * 16;
            const LAS unsigned char* Vb = lds + VOFF0 + vcur + ((DF ? 0 : sub * 64) + r32) * VROW + hi * 16;
            f32x16 p0 = DF ? negm : f32x16{}, p1 = p0;
            bf16x8 kf[8];
#pragma unroll
            for (int d0 = 0; d0 < 4; ++d0) { kf[2 * d0] = *(const LAS bf16x8*)(Kb + d0 * 32); kf[2 * d0 + 1] = *(const LAS bf16x8*)(Kb + 32 * KROW + d0 * 32); }
            __builtin_amdgcn_sched_barrier(0);
#pragma unroll
            for (int d0 = 0; d0 < 4; ++d0) { p0 = MFMA32(kf[2 * d0], qf[d0], p0); p1 = MFMA32(kf[2 * d0 + 1], qf[d0], p1); }
            if (!DF) {
                float nb[32];
#pragma unroll
                for (int e = 0; e < 32; ++e) { const float z = e < 16 ? p0[e] : p1[e - 16];
                    nb[e] = __builtin_amdgcn_rcpf(1.f + __builtin_amdgcn_exp2f(z)); }
                if (j == jd) {
                    const int tq = t0 + r32 - 64 * j;
#pragma unroll
                    for (int e = 0; e < 32; ++e) { const int kk = (e & 3) + 8 * ((e & 15) >> 2) + 4 * hi + 32 * (e >> 4); const bool ok = kk < tq;
                        nb[e] = ok ? nb[e] : 1.f; }
                }
                float SI[9], SIp[9];
                SI[8] = 1.f; SIp[8] = 1.f;
#pragma unroll
                for (int i = 7; i >= 0; --i) SI[i] = SI[i + 1] * ((nb[4 * i] * nb[4 * i + 1]) * (nb[4 * i + 2] * nb[4 * i + 3]));
#pragma unroll
                for (int i = 0; i < 8; ++i) SIp[i] = partner(SI[i]);
                float w[32];
#pragma unroll
                for (int i = 0; i < 8; ++i) {
                    const float a3 = carry * SI[i + 1] * (hi ? SIp[i + 1] : SIp[i]);
                    const float a2 = a3 * nb[4 * i + 3], a1 = a2 * nb[4 * i + 2], a0 = a1 * nb[4 * i + 1], ae = a0 * nb[4 * i];
                    w[4 * i + 3] = a3 - a2; w[4 * i + 2] = a2 - a1; w[4 * i + 1] = a1 - a0; w[4 * i] = a0 - ae;
                }
                carry *= SI[0] * SIp[0];
                done = __all(carry < SB_EXIT);
                __builtin_amdgcn_sched_barrier(0);
                bf16x8 vfa[8];
                ATT_VFRAG(vfa, Vb, 0);
                bf16x8 pw[4];
#pragma unroll
                for (int ks = 0; ks < 4; ++ks) pw[ks] = pack8(w[8 * ks], w[8 * ks + 1], w[8 * ks + 2], w[8 * ks + 3], w[8 * ks + 4], w[8 * ks + 5], w[8 * ks + 6], w[8 * ks + 7]);
                __builtin_amdgcn_sched_barrier(0);
#pragma unroll
                for (int ks = 0; ks < 4; ++ks) { o[0] = MFMA32(vfa[ks], pw[ks], o[0]); o[1] = MFMA32(vfa[4 + ks], pw[ks], o[1]); }
            } else {
                const LAS unsigned char* Vp = lds + VOFF0 + vprev + r32 * VROW + hi * 16;
                { bf16x8 vfa[8];
                  ATT_VFRAG(vfa, Vp, 0);
#pragma unroll
                  for (int ks = 0; ks < 4; ++ks) { o[0] = MFMA32(vfa[ks], pk[ks], o[0]); o[1] = MFMA32(vfa[4 + ks], pk[ks], o[1]); } }
                float ra = max3f(p0[0], p0[1], p1[0]), rb = max3f(p0[2], p0[3], p1[1]); ra = max3f(ra, p1[2], p1[3]);
#pragma unroll
                for (int r = 4; r < 16; r += 4) { ra = max3f(ra, p0[r], p0[r + 1]); rb = max3f(rb, p0[r + 2], p0[r + 3]); ra = max3f(ra, p1[r], p1[r + 1]); rb = max3f(rb, p1[r + 2], p1[r + 3]); }
                float rm = max3f(ra, rb, rb); rm = max3f(rm, partner(rm), rm);
                const bool need = __any(rm > DF_THR) || first;
                float scl = 1.f;
                if (need) {
                    const float dl = first ? rm : fmaxf(rm, 0.f); carry += dl;
#pragma unroll
                    for (int r = 0; r < 16; ++r) { p0[r] -= dl; p1[r] -= dl; }
#pragma unroll
                    for (int r = 0; r < 16; ++r) negm[r] = -carry;
                    scl = first ? 1.f : __builtin_amdgcn_exp2f(-dl); lsum *= scl;
                    first = false;
                }
                bf16x8 vfb[8];
#define ATT_VFRAG4(ks0) do { _Pragma("unroll") for (int i_ = 0; i_ < 4; ++i_) { const int dd_ = 2 + (i_ >> 1), ks_ = (ks0) + (i_ & 1); vfb[(dd_ - 2) * 4 + ks_] = *(const LAS bf16x8*)(Vp + dd_ * 32 * VROW + ks_ * 32); } } while (0)
                ATT_VFRAG4(0);
                float sa = 0.f, sb = 0.f;
                u32x4 pnw[4];
                typedef __bf16 bf2_t __attribute__((ext_vector_type(2)));
                const bf2_t ones2 = {(__bf16)1.0f, (__bf16)1.0f};
#pragma unroll
                for (int i = 0; i < 8; ++i) {
                    __builtin_amdgcn_sched_barrier(0);
                    if (i == 1) { ATT_VFRAG4(2); __builtin_amdgcn_sched_barrier(0); }
                    if (i & 1) o[ND - 1] = MFMA32(vfb[4 + (i >> 1)], pk[i >> 1], o[ND - 1]); else o[ND - 2] = MFMA32(vfb[i >> 1], pk[i >> 1], o[ND - 2]);
                    __builtin_amdgcn_sched_barrier(0);
                    const int r0 = 4 * (i & 3);
                    const float e0 = __builtin_amdgcn_exp2f(i < 4 ? p0[r0] : p1[r0]), e1 = __builtin_amdgcn_exp2f(i < 4 ? p0[r0 + 1] : p1[r0 + 1]);
                    const float e2 = __builtin_amdgcn_exp2f(i < 4 ? p0[r0 + 2] : p1[r0 + 2]), e3 = __builtin_amdgcn_exp2f(i < 4 ? p0[r0 + 3] : p1[r0 + 3]);
                    const unsigned w0 = cvtpk(e0, e1), w1 = cvtpk(e2, e3);
                    sa = __builtin_amdgcn_fdot2_f32_bf16(__builtin_bit_cast(bf2_t, w0), ones2, sa, false);
                    sb = __builtin_amdgcn_fdot2_f32_bf16(__builtin_bit_cast(bf2_t, w1), ones2, sb, false);
                    pnw[(i >> 2) * 2 + ((i & 3) >> 1)][2 * (i & 1)] = w0; pnw[(i >> 2) * 2 + ((i & 3) >> 1)][2 * (i & 1) + 1] = w1;
                }
                __builtin_amdgcn_sched_barrier(0);
                float s = sa + sb;
                bf16x8 pn[4];
#pragma unroll
                for (int ks = 0; ks < 4; ++ks) pn[ks] = __builtin_bit_cast(bf16x8, pnw[ks]);
#pragma unroll
                for (int ks = 0; ks < 4; ++ks) asm volatile("" : "+v"(pn[ks]));
                asm volatile("" : "+v"(s));
                if (need) {
#pragma unroll
                    for (int dd = 0; dd < ND; ++dd)
#pragma unroll
                        for (int r = 0; r < 16; ++r) o[dd][r] *= scl;
                }
#pragma unroll
                for (int ks = 0; ks < 4; ++ks) pk[ks] = pn[ks];
                lsum += s;
            }
        }
        ATT_LSTORE(kcur ^ KBUF, vnext, KS, VS);
        ATT_GLOAD(KS, VS, (j > 3 ? j - 3 : 0));
        if (!DF) { if (lane == 0) flags[(kcur ? 8 : 0) + wid] = done ? 1u : 0u; }
        __syncthreads();
        vprev = vcur; vcur = vnext;
        if (!DF) {
            const u32x4 f0 = *(const LAS u32x4*)(lds + FLAGS_OFF + (kcur ? 32 : 0)), f1 = *(const LAS u32x4*)(lds + FLAGS_OFF + (kcur ? 32 : 0) + 16);
            if ((f0.x & f0.y & f0.z & f0.w & f1.x & f1.y & f1.z & f1.w) != 0u) return true;
        }
        return false;
    };
    for (int j = jt; j >= 0; j -= 2) {
        if (step(j, 0, kB, vB)) break;
        if (j == 0) break;
        if (step(j - 1, KBUF, kA, vA)) break;
    }
    if (DF) {
        const LAS unsigned char* Vp = lds + VOFF0 + vprev + r32 * VROW + hi * 16;
        bf16x8 vfa[8], vfb[8];
        ATT_VFRAG(vfa, Vp, 0); ATT_VFRAG(vfb, Vp, 2);
#pragma unroll
        for (int ks = 0; ks < 4; ++ks) { o[0] = MFMA32(vfa[ks], pk[ks], o[0]); o[1] = MFMA32(vfa[4 + ks], pk[ks], o[1]); }
#pragma unroll
        for (int ks = 0; ks < 4; ++ks) { o[ND - 2] = MFMA32(vfb[ks], pk[ks], o[ND - 2]); o[ND - 1] = MFMA32(vfb[4 + ks], pk[ks], o[ND - 1]); }
        __syncthreads();
    }
    __builtin_amdgcn_s_setprio(0);
#undef ATT_GLOAD
#undef ATT_LSTORE
#undef ATT_VFRAG
#undef ATT_VFRAG4
    if (!DF) {
        bf16_t* yp = Y + (tokbase + t0 + r32) * 512 + (2 * h + sub) * 64 + 4 * hi;
#pragma unroll
        for (int dd = 0; dd < ND; ++dd)
#pragma unroll
            for (int r4 = 0; r4 < 4; ++r4) { u32x2 w; w.x = cvtpk(o[dd][4 * r4], o[dd][4 * r4 + 1]); w.y = cvtpk(o[dd][4 * r4 + 2], o[dd][4 * r4 + 3]); *(u32x2*)(yp + dd * 32 + r4 * 8) = w; }
    } else {
        const float ltot = lsum + partner(lsum);
        const float inv = 1.f / ltot;
        LAS float* X = (LAS float*)lds + (size_t)wq * 4096;
        if (sub == 1) {
            const float f = lam * inv;
#pragma unroll
            for (int dd = 0; dd < ND; ++dd)
#pragma unroll
                for (int r = 0; r < 16; ++r) X[(dd * 32 + (r & 3) + 8 * (r >> 2) + 4 * hi) * 32 + r32] = o[dd][r] * f;
        }
        __syncthreads();
        if (sub == 0) {
            float ss = 0.f;
#pragma unroll
            for (int dd = 0; dd < ND; ++dd)
#pragma unroll
                for (int r = 0; r < 16; ++r) { const float v = o[dd][r] * inv - X[(dd * 32 + (r & 3) + 8 * (r >> 2) + 4 * hi) * 32 + r32]; o[dd][r] = v; ss += v * v; }
            ss += partner(ss);
            const float rstd = __builtin_amdgcn_rsqf(ss * (1.f / 128.f) + EPS) * (1.f - LAMBDA_INIT);
            bf16_t* yp = Y + (size_t)M * 512 + (tokbase + t0 + r32) * 512 + h * 128 + 4 * hi;
#pragma unroll
            for (int dd = 0; dd < ND; ++dd)
#pragma unroll
                for (int r4 = 0; r4 < 4; ++r4) { const f32x4 g = *(const f32x4*)(g_subln + dd * 32 + r4 * 8 + 4 * hi);
                    u32x2 w; w.x = cvtpk(o[dd][4 * r4] * rstd * g[0], o[dd][4 * r4 + 1] * rstd * g[1]); w.y = cvtpk(o[dd][4 * r4 + 2] * rstd * g[2], o[dd][4 * r4 + 3] * rstd * g[3]);
                    *(u32x2*)(yp + dd * 32 + r4 * 8) = w; }
        }
        __syncthreads();
    }
}
}


#define XB_TMO      128
#define XB_XCNT(j)  (256  + 64 * (j))
#define XB_XSUB(j)  (1280 + 64 * (j))
#define XB_XGEN(j)  (2304 + 64 * (j))
#define XB_TOP      3328
#define XB_TOPGEN   3392
#define XCD_BAR_WORDS 3456
#define XB_SPIN_CAP (1u << 21)
__device__ __forceinline__ unsigned xb_ld(unsigned* p)              { return __hip_atomic_load(p, __ATOMIC_RELAXED, __HIP_MEMORY_SCOPE_AGENT); }
__device__ __forceinline__ unsigned xb_add(unsigned* p, unsigned v) { return __hip_atomic_fetch_add(p, v, __ATOMIC_RELAXED, __HIP_MEMORY_SCOPE_AGENT); }
__device__ __forceinline__ unsigned xb_xcc_id() { return (unsigned)__builtin_amdgcn_s_getreg((3 << 11) | 20) & 0xFu; }
#define XB_SPIN(cond, bar) do { unsigned _sp = 0; while (cond) { __builtin_amdgcn_s_sleep(1); \
    if ((++_sp & 255u) == 0u) { if (xb_ld(&(bar)[XB_TMO])) break; if (_sp > XB_SPIN_CAP) { atomicAdd(&(bar)[XB_TMO], 1u); break; } } } } while (0)
struct XcdBarrier { unsigned* bar; unsigned x; volatile LAS unsigned* st; };
__device__ __forceinline__ XcdBarrier xcd_barrier_post(unsigned* bar, volatile LAS unsigned* st) {
    XcdBarrier b; b.bar = bar; b.x = xb_xcc_id(); b.st = st;
    if (threadIdx.x == 0) (void)xb_add(&bar[XB_XCNT(b.x)], 1u);
    return b;
}
__device__ __forceinline__ void xcd_barrier_complete(unsigned* bar, unsigned x, unsigned& nloc, unsigned& nx) {
    const unsigned G = gridDim.x * gridDim.y * gridDim.z;
    unsigned sum, cnt, mine, sp = 0u;
    for (;;) {
        sum = 0u; cnt = 0u; mine = 0u;
#pragma unroll
        for (unsigned j = 0; j < 16; ++j) { const unsigned c = xb_ld(&bar[XB_XCNT(j)]); sum += c; cnt += (c > 0u) ? 1u : 0u; mine = (j == x) ? c : mine; }
        if (sum == G) break;
        __builtin_amdgcn_s_sleep(1);
        if ((++sp & 255u) == 0u) { if (xb_ld(&bar[XB_TMO])) break; if (sp > XB_SPIN_CAP) { atomicAdd(&bar[XB_TMO], 1u); break; } }
    }
    nloc = mine > 0u ? mine : 1u; nx = cnt > 0u ? cnt : 1u;
}
__device__ __forceinline__ void xcd_barrier(const XcdBarrier& b) {
    asm volatile("s_waitcnt vmcnt(0)" ::: "memory");
    __syncthreads();
    if (threadIdx.x == 0) {
        unsigned* bar = b.bar;
        __builtin_amdgcn_s_waitcnt(0);
        unsigned nloc = b.st[0], nx = b.st[1];
        if (nloc == 0u) { xcd_barrier_complete(bar, b.x, nloc, nx); b.st[0] = nloc; b.st[1] = nx; }
        const unsigned old = xb_add(&bar[XB_XSUB(b.x)], 1u);
        const unsigned gen = old / nloc;
        if (old + 1u == (gen + 1u) * nloc) {
            __builtin_amdgcn_fence(__ATOMIC_RELEASE, "agent");
            asm volatile("s_waitcnt vmcnt(0)" ::: "memory");
            const unsigned og = xb_add(&bar[XB_TOP], 1u);
            const unsigned tg = og / nx;
            if (og + 1u == (tg + 1u) * nx) xb_add(&bar[XB_TOPGEN], 1u);
            else XB_SPIN(xb_ld(&bar[XB_TOPGEN]) == tg, bar);
            __builtin_amdgcn_fence(__ATOMIC_ACQUIRE, "agent");
            xb_add(&bar[XB_XGEN(b.x)], 1u);
            asm volatile("s_waitcnt vmcnt(0)" ::: "memory");
        } else {
            XB_SPIN(xb_ld(&bar[XB_XGEN(b.x)]) == gen, bar);
            __builtin_amdgcn_fence(__ATOMIC_ACQUIRE, "agent");
            asm volatile("s_waitcnt vmcnt(0)" ::: "memory");
        }
    }
    __syncthreads();
}

constexpr int NWAVES = 8, NPHASE = 10;
#ifndef PROBE_REPS
#define PROBE_REPS 0
#define PROBE_MASK 0x8
#endif
constexpr int LDS_BYTES = 147456;
constexpr int MISC_OFF = 131072;

struct Args { const void* in[22]; float* out; unsigned char* ws; int ph_lo, ph_hi; };

__device__ __forceinline__ float wave_sum(float v) {
#pragma unroll
    for (int o = 1; o < 64; o <<= 1) v += __shfl_xor(v, o);
    return v;
}
template <int MAP> __device__ __forceinline__ int rowmap(int n) {
    if (MAP == 0) return n;
    if (MAP == 2) return 2048 + n;
    const int sec = n >> 9, r = n & 511;
    if (sec <= 1) return n;
    if (sec == 2) return 4096 + r;
    if (sec == 5) return 4608 + r;
    const int e = r >> 6, d = r & 63, p = (d < 32) ? 2 * d : 2 * (d - 32) + 1;
    return (sec == 3 ? 1024 : 1536) + e * 64 + p;
}
template <int MAP> __device__ __forceinline__ void transpose_item(const float* __restrict__ W, int K, int N, bf16_t* __restrict__ WT, LAS float* scr, int item, int lane) {
    const int nblk = N / 32, kb = item / nblk, nb = item % nblk, k0 = 64 * kb, n0 = 32 * nb;
    { const int kk0 = lane >> 3, c4 = lane & 7; f32x4 v[8];
#pragma unroll
      for (int i = 0; i < 8; ++i) v[i] = *(const f32x4*)(W + (size_t)(k0 + kk0 + 8 * i) * N + n0 + 4 * c4);
#pragma unroll
      for (int i = 0; i < 8; ++i) { LAS float* p = scr + (kk0 + 8 * i) * 33 + 4 * c4; p[0] = v[i].x; p[1] = v[i].y; p[2] = v[i].z; p[3] = v[i].w; } }
    asm volatile("s_waitcnt lgkmcnt(0)" ::: "memory");
    const int c = lane & 7;
#pragma unroll
    for (int j = 0; j < 4; ++j) { const int n = (lane >> 3) + 8 * j; const LAS float* s = scr + (8 * c) * 33 + n;
        u32x4 o; o.x = cvtpk(s[0 * 33], s[1 * 33]); o.y = cvtpk(s[2 * 33], s[3 * 33]); o.z = cvtpk(s[4 * 33], s[5 * 33]); o.w = cvtpk(s[6 * 33], s[7 * 33]);
        *(u32x4*)(WT + (size_t)rowmap<MAP>(n0 + n) * K + k0 + 8 * c) = o; }
    asm volatile("s_waitcnt lgkmcnt(0)" ::: "memory");
}

__global__ void __launch_bounds__(NWAVES * 64, 2) fwd_kernel(Args args) {
    extern __shared__ __attribute__((aligned(16))) unsigned char lds_raw[];
    LAS unsigned char* lds = (LAS unsigned char*)lds_raw;
    const int tid0 = threadIdx.x, wave = __builtin_amdgcn_readfirstlane(tid0 >> 6);
    const int G = gridDim.x, bx = blockIdx.x;
    const int vcu = (G % 8 == 0) ? (bx % 8) * (G / 8) + bx / 8 : bx;
    const int gw = vcu * NWAVES + wave, NGW = G * NWAVES;

    const float* x = (const float*)args.in[0]; const float* cc = (const float*)args.in[1]; const int* pos = (const int*)args.in[2];
    const float* w_ada = (const float*)args.in[3]; const float* b_ada = (const float*)args.in[4]; const float* g_pre_mix = (const float*)args.in[5];
    const float* w_in = (const float*)args.in[6];
    const float* lq1 = (const float*)args.in[7]; const float* lk1 = (const float*)args.in[8]; const float* lq2 = (const float*)args.in[9]; const float* lk2 = (const float*)args.in[10];
    const float* g_subln = (const float*)args.in[11]; const float* w_bsb = (const float*)args.in[12]; const float* w_bdf = (const float*)args.in[13];
    const float* w_gate = (const float*)args.in[14]; const float* b_gate = (const float*)args.in[15]; const float* w_out = (const float*)args.in[16];
    const float* g_post_mix = (const float*)args.in[17]; const float* g_pre_ffn = (const float*)args.in[18];
    const float* w_ff1 = (const float*)args.in[19]; const float* w_ff2 = (const float*)args.in[20]; const float* g_post_ffn = (const float*)args.in[21];
    float* out = args.out; unsigned char* ws = args.ws;
    float* mod = (float*)(ws + CTL_MOD); float* rss1 = (float*)(ws + CTL_RSS1); float* rss2 = (float*)(ws + CTL_RSS2); unsigned* queue = (unsigned*)(ws + CTL_QUEUE);
    float* rss3 = (float*)(ws + CTL_RSS3); unsigned* pcnt = (unsigned*)(ws + CTL_PCNT);
#define fused ({ int g_ = (int)gridDim.x; asm volatile("" : "+s"(g_)); g_ == 256; })
    bf16_t* WCAT = (bf16_t*)(ws + WS_WCAT); bf16_t* WBSB = (bf16_t*)(ws + WS_WBSB); bf16_t* WBDF = (bf16_t*)(ws + WS_WBDF); bf16_t* WOUT = (bf16_t*)(ws + WS_WOUT);
    bf16_t* WFF1 = (bf16_t*)(ws + WS_WFF1); bf16_t* WFF2 = (bf16_t*)(ws + WS_WFF2);
    bf16_t* BUFA = (bf16_t*)(ws + WS_BUFA); bf16_t* QK = (bf16_t*)(ws + WS_QK); bf16_t* GATE = (bf16_t*)(ws + WS_GATE); bf16_t* FB = (bf16_t*)(ws + WS_F);
    bf16_t* VT = (bf16_t*)(ws + WS_VT); bf16_t* MB = (bf16_t*)(ws + WS_VT); bf16_t* MG = (bf16_t*)(ws + WS_MG); bf16_t* F2 = (bf16_t*)(ws + WS_MG);

    cg::grid_group grid = cg::this_grid();
    const int lo = args.ph_lo, hi_ph = args.ph_hi;
    if (tid0 < 64) ((LAS unsigned*)(lds + MISC_OFF))[tid0] = 0u;
    __syncthreads();
    const XcdBarrier bar = xcd_barrier_post((unsigned*)(ws + CTL_BAR), (volatile LAS unsigned*)(lds + MISC_OFF + 32));
#define GRID_BAR() do { if (lo < 0) grid.sync(); else xcd_barrier(bar); } while (0)
    using SO = pg8::StaticOrder;

    for (int ph = lo; ph < hi_ph; ++ph) {
#if PROBE_REPS
      for (int rep = 0; rep <= ((((PROBE_MASK) >> ph) & 1) ? PROBE_REPS : 0); ++rep) {
        if (rep) GRID_BAR();
#else
      { const int rep = 0;
#endif
        int tid = tid0; asm volatile("" : "+v"(tid));
        const int lane = tid & 63;
        if (ph == 0) {
            const bool gemv = bx < 96;
            for (int cgi = bx; cgi < 96; cgi += G) {
                LAS float* sc = (LAS float*)lds;
                for (int i = tid; i < 4096; i += 512) { const float cv = cc[i]; sc[i] = cv / (1.f + __expf(-cv)); }
                __syncthreads();
                const int col = 64 * cgi + lane; const float* wp = w_ada + (size_t)(128 * wave) * 6144 + col;
                float a0 = 0.f, a1 = 0.f, a2 = 0.f, a3 = 0.f;
#pragma unroll 1
                for (int d0 = 0; d0 < 128; d0 += 32) { float wv[32];
#pragma unroll
                    for (int dd = 0; dd < 32; ++dd) wv[dd] = wp[(size_t)(d0 + dd) * 6144];
#pragma unroll
                    for (int dd = 0; dd < 32; ++dd) { const int d = 128 * wave + d0 + dd; a0 += wv[dd] * sc[d]; a1 += wv[dd] * sc[1024 + d]; a2 += wv[dd] * sc[2048 + d]; a3 += wv[dd] * sc[3072 + d]; } }
                LAS float* part = (LAS float*)(lds + 16384) + wave * 256;
                part[lane] = a0; part[64 + lane] = a1; part[128 + lane] = a2; part[192 + lane] = a3;
                __syncthreads();
                if (tid < 256) { float sum = b_ada[64 * cgi + (tid & 63)];
#pragma unroll
                    for (int w_ = 0; w_ < 8; ++w_) sum += ((LAS float*)(lds + 16384))[w_ * 256 + tid];
                    mod[(tid >> 6) * 6144 + 64 * cgi + (tid & 63)] = sum; }
                __syncthreads();
            }
            { LAS float* scr = (LAS float*)(lds + wave * 16384);
              constexpr int I_IN = 16 * 96, I_GATE = 16 * 64, I_BS = 8 * 32, I_OUT = 16 * 32, I_FF1 = 16 * 128, I_FF2 = 64 * 32;
              constexpr int NITEMS = I_IN + I_GATE + 2 * I_BS + I_OUT + I_FF1 + I_FF2;
              constexpr int NSLOT = 160 * 16 + 96 * 8;
              const int slot0 = gemv ? 2560 + bx * 8 + wave : (bx - 96) * 16 + wave * 2, nsl = gemv ? 1 : 2;
              if (G == 256) {
                for (int base = slot0; base < NITEMS; base += NSLOT)
                  for (int q_ = 0; q_ < nsl; ++q_) { int r = base + q_; if (r >= NITEMS) break;
                    if (r < I_IN) { transpose_item<1>(w_in, 1024, 3072, WCAT, scr, r, lane); continue; } r -= I_IN;
                    if (r < I_GATE) { transpose_item<2>(w_gate, 1024, 2048, WCAT, scr, r, lane); continue; } r -= I_GATE;
                    if (r < I_BS) { transpose_item<0>(w_bsb, 512, 1024, WBSB, scr, r, lane); continue; } r -= I_BS;
                    if (r < I_BS) { transpose_item<0>(w_bdf, 512, 1024, WBDF, scr, r, lane); continue; } r -= I_BS;
                    if (r < I_OUT) { transpose_item<0>(w_out, 1024, 1024, WOUT, scr, r, lane); continue; } r -= I_OUT;
                    if (r < I_FF1) { transpose_item<0>(w_ff1, 1024, 4096, WFF1, scr, r, lane); continue; } r -= I_FF1;
                    transpose_item<0>(w_ff2, 4096, 1024, WFF2, scr, r, lane); }
              } else {
                for (int it = gw; it < NITEMS; it += NGW) { int r = it;
                    if (r < I_IN) { transpose_item<1>(w_in, 1024, 3072, WCAT, scr, r, lane); continue; } r -= I_IN;
                    if (r < I_GATE) { transpose_item<2>(w_gate, 1024, 2048, WCAT, scr, r, lane); continue; } r -= I_GATE;
                    if (r < I_BS) { transpose_item<0>(w_bsb, 512, 1024, WBSB, scr, r, lane); continue; } r -= I_BS;
                    if (r < I_BS) { transpose_item<0>(w_bdf, 512, 1024, WBDF, scr, r, lane); continue; } r -= I_BS;
                    if (r < I_OUT) { transpose_item<0>(w_out, 1024, 1024, WOUT, scr, r, lane); continue; } r -= I_OUT;
                    if (r < I_FF1) { transpose_item<0>(w_ff1, 1024, 4096, WFF1, scr, r, lane); continue; } r -= I_FF1;
                    transpose_item<0>(w_ff2, 4096, 1024, WFF2, scr, r, lane); }
              } }
        } else if (ph == 1) {
            for (int m0 = gw * 8; m0 < M; m0 += NGW * 8) {
                const float* mb = mod + (m0 >> 12) * 6144;
                f32x4 ga[4], sh[4];
#pragma unroll
                for (int j = 0; j < 4; ++j) { const int col = 4 * lane + 256 * j; ga[j] = *(const f32x4*)(g_pre_mix + col) * (*(const f32x4*)(mb + 1024 + col) + 1.f); sh[j] = *(const f32x4*)(mb + col); }
                f32x4 nv[4];
#pragma unroll
                for (int j = 0; j < 4; ++j) nv[j] = ((const f32x4*)(x + (size_t)m0 * DM) + lane)[64 * j];
#pragma unroll 2
                for (int r = 0; r < 8; ++r) { const int m = m0 + r;
                    f32x4 v[4]; float s = 0.f;
#pragma unroll
                    for (int j = 0; j < 4; ++j) v[j] = nv[j];
                    if (r < 7) {
#pragma unroll
                        for (int j = 0; j < 4; ++j) nv[j] = ((const f32x4*)(x + (size_t)(m + 1) * DM) + lane)[64 * j]; }
#pragma unroll
                    for (int j = 0; j < 4; ++j) s += (v[j].x * v[j].x + v[j].y * v[j].y) + (v[j].z * v[j].z + v[j].w * v[j].w);
                    const float rstd = __builtin_amdgcn_rsqf(wave_sum(s) * (1.f / DM) + EPS);
                    u32x2* o8 = (u32x2*)(BUFA + (size_t)m * DM) + lane;
#pragma unroll
                    for (int j = 0; j < 4; ++j) { const f32x4 hv = v[j] * rstd * ga[j] + sh[j]; o8[64 * j] = (u32x2){cvtpk(hv.x, hv.y), cvtpk(hv.z, hv.w)}; }
                }
            }
        } else if (ph == 2) {
            static_assert((WS_WCAT + (size_t)4096 * 1024 * 2) + 44 * (size_t)(256 * 1024 * 2) == WS_BUFA && WS_WCAT + 60 * (size_t)(256 * 1024 * 2) == WS_BUFA, "V^T units address Wv / h as tiles of the h / W base pointers");
            if (G == 256) {
                pg8::Gemm g{BUFA, WCAT, M, 4096, 1024}; pg8::TwoOrder S; S.a.init(M, 4096, G, bx); S.b.init(1024, M, G, bx); S.na = 4; S.dpm = -44; S.dpn = 60;
                pg8::EpiProj E{QK, GATE, b_gate, pos, VT};
                pg8::gemm_phase<pg8::EpiProj, pg8::TwoOrder, true, true>(lds, g, S, E);
            } else {
            { pg8::Gemm g{BUFA, WCAT, M, 4096, 1024}; SO S; S.init(M, 4096, G, bx); pg8::EpiProj E{QK, GATE, b_gate, pos, VT};
              pg8::gemm_phase<pg8::EpiProj, SO, true, true>(lds, g, S, E); }
            { pg8::Gemm g{WCAT + (size_t)4096 * 1024, BUFA, 1024, M, 1024}; SO S; S.init(1024, M, G, bx); pg8::EpiPlain E{VT, M};
              pg8::gemm_phase<pg8::EpiPlain, SO, true, true>(lds, g, S, E); }
            }
        } else if (ph == 3) {
            float lam;
            { const float s1 = wave_sum(lq1[lane] * lk1[lane]), s2 = wave_sum(lq2[lane] * lk2[lane]); lam = __expf(s1) - __expf(s2) + LAMBDA_INIT; }
            volatile LAS unsigned* uword = (volatile LAS unsigned*)(lds + MISC_OFF);
            for (;;) {
                if (tid == 0) uword[0] = atomicAdd(queue + rep, 1u);
                __syncthreads();
                const unsigned idx = uword[0];
                __syncthreads();
                if (idx >= 1024u) break;
                if (idx < 512u) { const int r2 = idx & 15; att::attn_unit<true>(lds, QK, VT, BUFA, r2 >> 2, r2 & 3, 31 - (int)(idx >> 4), lam, g_subln); }
                else { const int i2 = idx - 512, r2 = i2 & 15; att::attn_unit<false>(lds, QK, VT, BUFA, r2 >> 2, r2 & 3, 31 - (i2 >> 4), 0.f, g_subln); }
            }
        } else if (ph == 4) {
            static_assert(WS_WBDF == WS_WBSB + (size_t)1024 * 512 * 2, "branch weights adjacent");
            pg8::Gemm g{BUFA, WBSB, M, 1024, 512}; pg8::PairOrder S; S.a.init(M, 1024, G, bx); S.dpm = 64; S.dpn = 4;
            pg8::EpiGate E{MG, GATE};
            pg8::gemm_phase<pg8::EpiGate, pg8::PairOrder, true, true>(lds, g, S, E);
        } else if (ph == 5) {
            pg8::Gemm g{MG, WOUT, M, 1024, 1024}; SO S; S.init(M, 1024, G, bx);
            if (fused) { pg8::EpiMid E{x, MB, BUFA, mod, g_post_mix, g_pre_ffn, pg8::PanelX{rss1, pcnt}, pg8::PanelX{rss3, pcnt + 4096}};
                pg8::gemm_phase<pg8::EpiMid, SO, true, true>(lds, g, S, E); }
            else { pg8::EpiSumsq E{MB, 1024, rss1}; pg8::gemm_phase<pg8::EpiSumsq, SO, true, true>(lds, g, S, E); }
        } else if (ph == 6 && !fused) {
            f32x4 nx[4]; u32x2 nm[4]; float nrs = rss1[gw];
#pragma unroll
            for (int j = 0; j < 4; ++j) { nx[j] = ((const f32x4*)(x + (size_t)gw * DM) + lane)[64 * j]; nm[j] = ((const u32x2*)(MB + (size_t)gw * DM) + lane)[64 * j]; }
            for (int m = gw; m < M; m += NGW) {
                const float* mb = mod + (m >> 12) * 6144;
                const float rm = __builtin_amdgcn_rsqf(nrs * (1.f / DM) + EPS);
                f32x4* xo = (f32x4*)(out + (size_t)m * DM) + lane;
                f32x4 xv[4]; u32x2 mvv[4];
#pragma unroll
                for (int j = 0; j < 4; ++j) { xv[j] = nx[j]; mvv[j] = nm[j]; }
                if (m + NGW < M) { nrs = rss1[m + NGW];
#pragma unroll
                    for (int j = 0; j < 4; ++j) { nx[j] = ((const f32x4*)(x + (size_t)(m + NGW) * DM) + lane)[64 * j]; nm[j] = ((const u32x2*)(MB + (size_t)(m + NGW) * DM) + lane)[64 * j]; } }
                f32x4 v[4]; float s = 0.f;
#pragma unroll
                for (int j = 0; j < 4; ++j) { const int col = 4 * lane + 256 * j; const u32x2 mv = mvv[j];
                    const f32x4 mf = {bflo(mv.x), bfhi(mv.x), bflo(mv.y), bfhi(mv.y)};
                    const f32x4 g = *(const f32x4*)(g_post_mix + col), gt = *(const f32x4*)(mb + 2048 + col);
                    v[j] = xv[j] + gt * (mf * rm * g); xo[64 * j] = v[j];
                    s += (v[j].x * v[j].x + v[j].y * v[j].y) + (v[j].z * v[j].z + v[j].w * v[j].w); }
                const float rstd = __builtin_amdgcn_rsqf(wave_sum(s) * (1.f / DM) + EPS);
                u32x2* o8 = (u32x2*)(BUFA + (size_t)m * DM) + lane;
#pragma unroll
                for (int j = 0; j < 4; ++j) { const int col = 4 * lane + 256 * j;
                    const f32x4 g = *(const f32x4*)(g_pre_ffn + col), sh = *(const f32x4*)(mb + 3072 + col), sc = *(const f32x4*)(mb + 4096 + col);
                    const f32x4 hv = v[j] * rstd * g * (sc + 1.f) + sh;
                    o8[64 * j] = (u32x2){cvtpk(hv.x, hv.y), cvtpk(hv.z, hv.w)}; }
            }
        } else if (ph == 7) {
            pg8::Gemm g{BUFA, WFF1, M, FF, 1024}; SO S; S.init(M, FF, G, bx); pg8::EpiRelu2 E{FB, FF};
            pg8::gemm_phase<pg8::EpiRelu2, SO, true, true>(lds, g, S, E);
        } else if (ph == 8) {
            pg8::Gemm g{FB, WFF2, M, 1024, FF}; SO S; S.init(M, 1024, G, bx);
            if (fused) { pg8::EpiFinal E{out, MB, mod, g_post_ffn, pg8::PanelX{rss2, pcnt + 8192}}; pg8::gemm_phase<pg8::EpiFinal, SO, true, true>(lds, g, S, E); }
            else { pg8::EpiSumsq E{F2, 1024, rss2}; pg8::gemm_phase<pg8::EpiSumsq, SO, true, true>(lds, g, S, E); }
        } else if (ph == 9 && !fused) {
            f32x4 nx[4]; u32x2 nm[4]; float nrs = rss2[gw];
#pragma unroll
            for (int j = 0; j < 4; ++j) { nx[j] = ((const f32x4*)(out + (size_t)gw * DM) + lane)[64 * j]; nm[j] = ((const u32x2*)(F2 + (size_t)gw * DM) + lane)[64 * j]; }
            for (int m = gw; m < M; m += NGW) {
                const float* mb = mod + (m >> 12) * 6144;
                const float rm = __builtin_amdgcn_rsqf(nrs * (1.f / DM) + EPS);
                f32x4* xo = (f32x4*)(out + (size_t)m * DM) + lane;
                f32x4 xv[4]; u32x2 mvv[4];
#pragma unroll
                for (int j = 0; j < 4; ++j) { xv[j] = nx[j]; mvv[j] = nm[j]; }
                if (m + NGW < M) { nrs = rss2[m + NGW];
#pragma unroll
                    for (int j = 0; j < 4; ++j) { nx[j] = ((const f32x4*)(out + (size_t)(m + NGW) * DM) + lane)[64 * j]; nm[j] = ((const u32x2*)(F2 + (size_t)(m + NGW) * DM) + lane)[64 * j]; } }
#pragma unroll
                for (int j = 0; j < 4; ++j) { const int col = 4 * lane + 256 * j; const u32x2 mv = mvv[j];
                    const f32x4 mf = {bflo(mv.x), bfhi(mv.x), bflo(mv.y), bfhi(mv.y)};
                    const f32x4 g = *(const f32x4*)(g_post_ffn + col), gt = *(const f32x4*)(mb + 5120 + col);
                    xo[64 * j] = xv[j] + gt * (mf * rm * g); }
            }
        }
      }
        if (ph + 1 < hi_ph && !(fused && (ph == 5 || ph == 8))) GRID_BAR();
    }
}

#ifndef N_LAUNCH_PER_PHASE
#define N_LAUNCH_PER_PHASE 0
#endif

extern "C" void kernel_launch(void* const* d_in, const int* in_sizes, int n_in, void* d_out, int out_size, void* d_ws, size_t ws_size, hipStream_t stream) {
    static int grid = 0;
    if (grid == 0) {
        if (n_in != 22 || ws_size < WS_END) { fprintf(stderr, "kernel_launch: unexpected n_in %d / ws %zu\n", n_in, ws_size); grid = -1; return; }
        int dev = 0, cus = 0, per_cu = 0;
        hipGetDevice(&dev); hipDeviceGetAttribute(&cus, hipDeviceAttributeMultiprocessorCount, dev);
        hipFuncSetAttribute((const void*)fwd_kernel, hipFuncAttributeMaxDynamicSharedMemorySize, LDS_BYTES);
        hipOccupancyMaxActiveBlocksPerMultiprocessor(&per_cu, (const void*)fwd_kernel, NWAVES * 64, LDS_BYTES);
        if (per_cu < 1) per_cu = 1;
        grid = cus * per_cu;
        (void)hipGetLastError();
    }
    if (grid < 0) return;
    hipMemsetAsync((char*)d_ws + WS_CTL, 0, CTL_ZERO_BYTES, stream);
    Args a{};
    for (int i = 0; i < 22; ++i) a.in[i] = d_in[i];
    a.out = (float*)d_out; a.ws = (unsigned char*)d_ws;
#if N_LAUNCH_PER_PHASE
    for (int p = 0; p < NPHASE; ++p) {
        a.ph_lo = p; a.ph_hi = p + 1;
        void* kargs[] = {&a};
        hipError_t e = hipLaunchCooperativeKernel((const void*)fwd_kernel, dim3(grid), dim3(NWAVES * 64), kargs, LDS_BYTES, stream);
        if (e != hipSuccess) { fprintf(stderr, "cooperative launch failed: %s (grid %d)\n", hipGetErrorString(e), grid); break; }
    }
#else
    a.ph_lo = 0; a.ph_hi = NPHASE;
    void* kargs[] = {&a};
    hipError_t e = hipLaunchCooperativeKernel((const void*)fwd_kernel, dim3(grid), dim3(NWAVES * 64), kargs, LDS_BYTES, stream);
    if (e != hipSuccess) fprintf(stderr, "cooperative launch failed: %s (grid %d)\n", hipGetErrorString(e), grid);
#endif
}
```

```cpp
#include <hip/hip_runtime.h>
#include <hip/hip_cooperative_groups.h>
#include <cstdio>
#include <cstdint>
namespace cg = cooperative_groups;

#define LAS __attribute__((address_space(3)))
typedef unsigned short bf16_t;
typedef short bf16x8 __attribute__((ext_vector_type(8)));
typedef float f32x4 __attribute__((ext_vector_type(4)));
typedef float f32x16 __attribute__((ext_vector_type(16)));
typedef unsigned u32x4 __attribute__((ext_vector_type(4)));
typedef unsigned u32x2 __attribute__((ext_vector_type(2)));
typedef float f32x2_t __attribute__((ext_vector_type(2)));
typedef __bf16 bf16x2_t __attribute__((ext_vector_type(2)));

__device__ __forceinline__ unsigned cvtpk(float lo, float hi) { f32x2_t v = {lo, hi}; bf16x2_t b = __builtin_convertvector(v, bf16x2_t); return __builtin_bit_cast(unsigned, b); }
__device__ __forceinline__ float bflo(unsigned u) { return __uint_as_float(u << 16); }
__device__ __forceinline__ float bfhi(unsigned u) { return __uint_as_float(u & 0xffff0000u); }

constexpr int DM = 1024, SEQ = 4096, NB = 4, M = NB * SEQ, FF = 4096;
constexpr float EPS = 1e-6f;
constexpr float C2 = 0.125f * 1.4426950408889634f;
constexpr float LAMBDA_INIT = 0.2f;

constexpr size_t MiB = 1u << 20;
constexpr size_t WS_CTL = 0, CTL_ZERO_BYTES = 1 * MiB;
constexpr size_t CTL_MOD = 0;
constexpr size_t CTL_RSS1 = 128 * 1024;
constexpr size_t CTL_RSS2 = 192 * 1024;
constexpr size_t CTL_QUEUE = 256 * 1024;
constexpr size_t CTL_RSS3 = 320 * 1024;
constexpr size_t CTL_PCNT = 384 * 1024;
constexpr size_t CTL_BAR = 512 * 1024;
constexpr size_t WS_WCAT = 2 * MiB;
constexpr size_t WS_WBSB = 12 * MiB;
constexpr size_t WS_WBDF = 13 * MiB;
constexpr size_t WS_WOUT = 14 * MiB;
constexpr size_t WS_WFF1 = 16 * MiB;
constexpr size_t WS_WFF2 = 24 * MiB;
constexpr size_t WS_BUFA = 32 * MiB;
constexpr size_t WS_QK = 64 * MiB;
constexpr size_t WS_GATE = 128 * MiB;
constexpr size_t WS_F = 64 * MiB;
constexpr size_t WS_VT = 192 * MiB;
constexpr size_t WS_MG = 224 * MiB;
constexpr size_t WS_END = 256 * MiB;

namespace pg8 {
constexpr int BM = 256, BK = 64, HALF = 128, HTB = HALF * BK * 2, STAGE_BYTES = 8 * HTB, NXCD = 8, WGM = 8;
__host__ __device__ __forceinline__ int lds_byte(int r, int c) { const int st = (r >> 4) * 2 + (c >> 5), rr = r & 15, cc = c & 31, ob = rr * 64 + cc * 2; return st * 1024 + (ob ^ (((ob >> 9) & 1) << 5)); }
__host__ __device__ __forceinline__ void stage_rc(int b, int& R, int& C) { const int st = b / 1024, sb = b % 1024, swz = sb ^ (((sb >> 9) & 1) << 5); R = (st >> 1) * 16 + swz / 64; C = (st & 1) * 32 + (swz % 64) / 2; }
__host__ __device__ __forceinline__ int perm32(int rho) { const int n = rho >> 4, i = rho & 15; return 8 * (i >> 2) + 4 * n + (i & 3); }
struct Unit { int pm, pn; };
struct Gemm { const bf16_t* A; const bf16_t* Bt; int M, N, K; };
struct StaticOrder {
    int nM, nN, nwg, G, c;
    __host__ __device__ void init(int M_, int N_, int G_, int c_) { nM = M_ / BM; nN = N_ / BM; nwg = nM * nN; G = G_; c = c_; }
    __host__ __device__ bool next(int i, Unit& u) const {
        const long L = (long)i * G + c; if (L >= nwg) return false;
        int wgid = (int)L; { const int q = nwg / NXCD, r = nwg % NXCD, xcd = wgid % NXCD, off = wgid / NXCD; wgid = (xcd < r ? xcd * (q + 1) : r * (q + 1) + (xcd - r) * q) + off; }
        const int nig = WGM * nN, gid = wgid / nig, fm = gid * WGM, gsz = (nM - fm) < WGM ? (nM - fm) : WGM;
        u.pm = fm + ((wgid % nig) % gsz); u.pn = (wgid % nig) / gsz; return true;
    }
    __device__ __forceinline__ void a_ready(const Unit&) const {}
    __device__ __forceinline__ void done(const Unit&) const {}
};

struct TwoOrder {
    StaticOrder a, b; int na, dpm, dpn;
    __device__ __forceinline__ bool next(int i, Unit& u) const {
        if (i < na) return a.next(i, u);
        if (!b.next(i - na, u)) return false;
        u.pm += dpm; u.pn += dpn; return true;
    }
    __device__ __forceinline__ void a_ready(const Unit&) const {}
    __device__ __forceinline__ void done(const Unit&) const {}
};
struct PairOrder {
    StaticOrder a; int dpm, dpn;
    __device__ __forceinline__ bool next(int i, Unit& u) const { if (!a.next(i >> 1, u)) return false; if (i & 1) { u.pm += dpm; u.pn += dpn; } return true; }
    __device__ __forceinline__ void a_ready(const Unit&) const {}
    __device__ __forceinline__ void done(const Unit&) const {}
};

struct EpiPlain {
    static constexpr bool PERM = true, AFTER_DRAIN = false;
    bf16_t* O; int ldc;
    __device__ __forceinline__ void operator()(const f32x4 (&acc)[2][2][4][2], const Unit& u, int wr, int wc, int fr, int fq) const {
        const int row0 = u.pm * BM + wr * 64 + fr, col0 = u.pn * BM + wc * 32 + 8 * fq;
#pragma unroll
        for (int ai = 0; ai < 2; ++ai)
#pragma unroll
            for (int m = 0; m < 4; ++m) { bf16_t* rowp = O + (size_t)(row0 + ai * HALF + m * 16) * ldc + col0;
#pragma unroll
                for (int bj = 0; bj < 2; ++bj) { const f32x4 v0 = acc[ai][bj][m][0], v1 = acc[ai][bj][m][1];
                    u32x4 w; w.x = cvtpk(v0[0], v0[1]); w.y = cvtpk(v0[2], v0[3]); w.z = cvtpk(v1[0], v1[1]); w.w = cvtpk(v1[2], v1[3]);
                    *(u32x4*)(rowp + bj * HALF) = w; } }
    }
};
struct EpiRelu2 {
    static constexpr bool PERM = true, AFTER_DRAIN = false;
    bf16_t* O; int ldc;
    __device__ __forceinline__ void operator()(const f32x4 (&acc)[2][2][4][2], const Unit& u, int wr, int wc, int fr, int fq) const {
        const int row0 = u.pm * BM + wr * 64 + fr, col0 = u.pn * BM + wc * 32 + 8 * fq;
#pragma unroll
        for (int ai = 0; ai < 2; ++ai)
#pragma unroll
            for (int m = 0; m < 4; ++m) { bf16_t* rowp = O + (size_t)(row0 + ai * HALF + m * 16) * ldc + col0;
#pragma unroll
                for (int bj = 0; bj < 2; ++bj) { f32x4 v0 = acc[ai][bj][m][0], v1 = acc[ai][bj][m][1];
#pragma unroll
                    for (int k = 0; k < 4; ++k) { const float a = fmaxf(v0[k], 0.f), b = fmaxf(v1[k], 0.f); v0[k] = a * a; v1[k] = b * b; }
                    u32x4 w; w.x = cvtpk(v0[0], v0[1]); w.y = cvtpk(v0[2], v0[3]); w.z = cvtpk(v1[0], v1[1]); w.w = cvtpk(v1[2], v1[3]);
                    *(u32x4*)(rowp + bj * HALF) = w; } }
    }
};
struct EpiSumsq {
    static constexpr bool PERM = true, AFTER_DRAIN = false;
    bf16_t* O; int ldc; float* rss;
    __device__ __forceinline__ void operator()(const f32x4 (&acc)[2][2][4][2], const Unit& u, int wr, int wc, int fr, int fq) const {
        const int row0 = u.pm * BM + wr * 64 + fr, col0 = u.pn * BM + wc * 32 + 8 * fq;
#pragma unroll
        for (int ai = 0; ai < 2; ++ai)
#pragma unroll
            for (int m = 0; m < 4; ++m) { const int row = row0 + ai * HALF + m * 16; bf16_t* rowp = O + (size_t)row * ldc + col0; float s = 0.f;
#pragma unroll
                for (int bj = 0; bj < 2; ++bj) { const f32x4 v0 = acc[ai][bj][m][0], v1 = acc[ai][bj][m][1];
                    s += (v0[0] * v0[0] + v0[1] * v0[1]) + (v0[2] * v0[2] + v0[3] * v0[3]) + (v1[0] * v1[0] + v1[1] * v1[1]) + (v1[2] * v1[2] + v1[3] * v1[3]);
                    u32x4 w; w.x = cvtpk(v0[0], v0[1]); w.y = cvtpk(v0[2], v0[3]); w.z = cvtpk(v1[0], v1[1]); w.w = cvtpk(v1[2], v1[3]);
                    *(u32x4*)(rowp + bj * HALF) = w; }
                s += __shfl_xor(s, 16); s += __shfl_xor(s, 32);
                if (fq == 0) unsafeAtomicAdd(rss + row, s); }
    }
};
struct PanelX {
    float* rss; unsigned* cnt;
    __device__ __forceinline__ void run(const float (&part)[2][4], float (&tot)[2][4], const Unit& u, int wr, int fr, int fq) const {
        const int row0 = u.pm * BM + wr * 64 + fr;
#pragma unroll
        for (int ai = 0; ai < 2; ++ai)
#pragma unroll
            for (int m = 0; m < 4; ++m) { float s = part[ai][m]; s += __shfl_xor(s, 16); s += __shfl_xor(s, 32);
                if (fq == 0) __hip_atomic_fetch_add(rss + row0 + ai * HALF + m * 16, s, __ATOMIC_RELAXED, __HIP_MEMORY_SCOPE_AGENT); }
        asm volatile("s_waitcnt vmcnt(0)" ::: "memory");
        __builtin_amdgcn_s_barrier();
        if (threadIdx.x == 0) {
            unsigned* c = cnt + 64 * u.pm;
            __hip_atomic_fetch_add(c, 1u, __ATOMIC_RELEASE, __HIP_MEMORY_SCOPE_AGENT);
            unsigned sp = 0;
            while (__hip_atomic_load(c, __ATOMIC_RELAXED, __HIP_MEMORY_SCOPE_AGENT) < 4u) { __builtin_amdgcn_s_sleep(1); if (++sp > (1u << 22)) break; }
            __builtin_amdgcn_fence(__ATOMIC_ACQUIRE, "agent");
        }
        asm volatile("s_waitcnt vmcnt(0) lgkmcnt(0)" ::: "memory");
        __builtin_amdgcn_s_barrier();
#pragma unroll
        for (int ai = 0; ai < 2; ++ai)
#pragma unroll
            for (int m = 0; m < 4; ++m) tot[ai][m] = __hip_atomic_load(rss + row0 + ai * HALF + m * 16, __ATOMIC_RELAXED, __HIP_MEMORY_SCOPE_AGENT);
    }
};
struct EpiFinal {
    static constexpr bool PERM = true, AFTER_DRAIN = false;
    float* out; const bf16_t* X1B; const float* mod; const float* g_post; PanelX px;
    __device__ __forceinline__ void operator()(const f32x4 (&acc)[2][2][4][2], const Unit& u, int wr, int wc, int fr, int fq) const {
        const int row0 = u.pm * BM + wr * 64 + fr, col0 = u.pn * BM + wc * 32 + 8 * fq;
        float part[2][4], tot[2][4];
#pragma unroll
        for (int ai = 0; ai < 2; ++ai)
#pragma unroll
            for (int m = 0; m < 4; ++m) { float s = 0.f;
#pragma unroll
                for (int bj = 0; bj < 2; ++bj) { const f32x4 v0 = acc[ai][bj][m][0], v1 = acc[ai][bj][m][1];
                    s += (v0[0] * v0[0] + v0[1] * v0[1]) + (v0[2] * v0[2] + v0[3] * v0[3]) + (v1[0] * v1[0] + v1[1] * v1[1]) + (v1[2] * v1[2] + v1[3] * v1[3]); }
                part[ai][m] = s; }
        px.run(part, tot, u, wr, fr, fq);
        const float* gtp = mod + ((u.pm * BM) >> 12) * 6144 + 5120 + col0;
#pragma unroll
        for (int bj = 0; bj < 2; ++bj) { f32x4 gg[2];
#pragma unroll
            for (int n = 0; n < 2; ++n) gg[n] = *(const f32x4*)(gtp + bj * HALF + 4 * n) * *(const f32x4*)(g_post + col0 + bj * HALF + 4 * n);
#pragma unroll
            for (int ai = 0; ai < 2; ++ai)
#pragma unroll
                for (int m = 0; m < 4; ++m) { const float rstd = __builtin_amdgcn_rsqf(tot[ai][m] * (1.f / 1024.f) + 1e-6f);
                    const size_t off = (size_t)(row0 + ai * HALF + m * 16) * 1024 + col0 + bj * HALF; float* op = out + off;
                    const u32x4 xb = *(const u32x4*)(X1B + off);
                    const f32x4 x0 = {bflo(xb.x), bfhi(xb.x), bflo(xb.y), bfhi(xb.y)}, x1v = {bflo(xb.z), bfhi(xb.z), bflo(xb.w), bfhi(xb.w)};
                    *(f32x4*)(op) = x0 + gg[0] * (acc[ai][bj][m][0] * rstd); *(f32x4*)(op + 4) = x1v + gg[1] * (acc[ai][bj][m][1] * rstd);
                    if (m & 1) asm volatile("" ::: "memory"); } }
    }
};
struct EpiMid {
    static constexpr bool PERM = true, AFTER_DRAIN = false;
    const float* x; bf16_t* X1B; bf16_t* H2; const float* mod; const float* g_post; const float* g_pre; PanelX px1, px2;
    __device__ __forceinline__ void operator()(f32x4 (&acc)[2][2][4][2], const Unit& u, int wr, int wc, int fr, int fq) const {
        const int row0 = u.pm * BM + wr * 64 + fr, col0 = u.pn * BM + wc * 32 + 8 * fq;
        float part[2][4], tot[2][4];
#pragma unroll
        for (int ai = 0; ai < 2; ++ai)
#pragma unroll
            for (int m = 0; m < 4; ++m) { float s = 0.f;
#pragma unroll
                for (int bj = 0; bj < 2; ++bj) { const f32x4 v0 = acc[ai][bj][m][0], v1 = acc[ai][bj][m][1];
                    s += (v0[0] * v0[0] + v0[1] * v0[1]) + (v0[2] * v0[2] + v0[3] * v0[3]) + (v1[0] * v1[0] + v1[1] * v1[1]) + (v1[2] * v1[2] + v1[3] * v1[3]); }
                part[ai][m] = s; }
        px1.run(part, tot, u, wr, fr, fq);
        const float* mb = mod + ((u.pm * BM) >> 12) * 6144;
#pragma unroll
        for (int ai = 0; ai < 2; ++ai)
#pragma unroll
            for (int m = 0; m < 4; ++m) part[ai][m] = 0.f;
#pragma unroll
        for (int bj = 0; bj < 2; ++bj) { f32x4 gg[2];
#pragma unroll
            for (int n = 0; n < 2; ++n) gg[n] = *(const f32x4*)(mb + 2048 + col0 + bj * HALF + 4 * n) * *(const f32x4*)(g_post + col0 + bj * HALF + 4 * n);
#pragma unroll
            for (int ai = 0; ai < 2; ++ai)
#pragma unroll
                for (int m = 0; m < 4; ++m) { const float rstd = __builtin_amdgcn_rsqf(tot[ai][m] * (1.f / 1024.f) + 1e-6f);
                    const size_t off = (size_t)(row0 + ai * HALF + m * 16) * 1024 + col0 + bj * HALF;
#pragma unroll
                    for (int n = 0; n < 2; ++n) { const f32x4 v = *(const f32x4*)(x + off + 4 * n) + gg[n] * (acc[ai][bj][m][n] * rstd); acc[ai][bj][m][n] = v;
                        part[ai][m] += (v[0] * v[0] + v[1] * v[1]) + (v[2] * v[2] + v[3] * v[3]); }
                    { const f32x4 v0 = acc[ai][bj][m][0], v1 = acc[ai][bj][m][1]; u32x4 w; w.x = cvtpk(v0[0], v0[1]); w.y = cvtpk(v0[2], v0[3]); w.z = cvtpk(v1[0], v1[1]); w.w = cvtpk(v1[2], v1[3]); *(u32x4*)(X1B + off) = w; }
                    if (m & 1) asm volatile("" ::: "memory"); } }
        px2.run(part, tot, u, wr, fr, fq);
#pragma unroll
        for (int bj = 0; bj < 2; ++bj) { f32x4 gg[2], sh[2];
#pragma unroll
            for (int n = 0; n < 2; ++n) { gg[n] = (*(const f32x4*)(mb + 4096 + col0 + bj * HALF + 4 * n) + 1.f) * *(const f32x4*)(g_pre + col0 + bj * HALF + 4 * n); sh[n] = *(const f32x4*)(mb + 3072 + col0 + bj * HALF + 4 * n); }
#pragma unroll
            for (int ai = 0; ai < 2; ++ai)
#pragma unroll
                for (int m = 0; m < 4; ++m) { const float rstd = __builtin_amdgcn_rsqf(tot[ai][m] * (1.f / 1024.f) + 1e-6f);
                    const f32x4 h0 = acc[ai][bj][m][0] * rstd * gg[0] + sh[0], h1 = acc[ai][bj][m][1] * rstd * gg[1] + sh[1];
                    u32x4 w; w.x = cvtpk(h0[0], h0[1]); w.y = cvtpk(h0[2], h0[3]); w.z = cvtpk(h1[0], h1[1]); w.w = cvtpk(h1[2], h1[3]);
                    *(u32x4*)(H2 + (size_t)(row0 + ai * HALF + m * 16) * 1024 + col0 + bj * HALF) = w; } }
    }
};
struct EpiGate {
    static constexpr bool PERM = true, AFTER_DRAIN = false;
    bf16_t* O; const bf16_t* G;
    __device__ __forceinline__ void operator()(f32x4 (&acc)[2][2][4][2], const Unit& u, int wr, int wc, int fr, int fq) const {
        const bool second = u.pm >= 64;
        const int row0 = (u.pm & 63) * BM + wr * 64 + fr, col0 = (u.pn & 3) * BM + wc * 32 + 8 * fq;
#pragma unroll
        for (int ai = 0; ai < 2; ++ai)
#pragma unroll
            for (int m = 0; m < 4; ++m) { const int row = row0 + ai * HALF + m * 16; bf16_t* rowp = O + (size_t)row * 1024 + col0; const bf16_t* gp = G + (size_t)row * 2048 + col0;
#pragma unroll
                for (int bj = 0; bj < 2; ++bj) {
                    const u32x4 d = *(const u32x4*)(gp + 1024 + bj * HALF);
                    f32x4 g0, g1;
                    g0[0] = fmaxf(bflo(d.x), 1e-30f); g0[1] = fmaxf(bfhi(d.x), 1e-30f); g0[2] = fmaxf(bflo(d.y), 1e-30f); g0[3] = fmaxf(bfhi(d.y), 1e-30f);
                    g1[0] = fmaxf(bflo(d.z), 1e-30f); g1[1] = fmaxf(bfhi(d.z), 1e-30f); g1[2] = fmaxf(bflo(d.w), 1e-30f); g1[3] = fmaxf(bfhi(d.w), 1e-30f);
                    if (second) { const f32x4 v0 = acc[ai][bj][m][0] * g0, v1 = acc[ai][bj][m][1] * g1;
                        u32x4 w; w.x = cvtpk(v0[0], v0[1]); w.y = cvtpk(v0[2], v0[3]); w.z = cvtpk(v1[0], v1[1]); w.w = cvtpk(v1[2], v1[3]);
                        *(u32x4*)(rowp + bj * HALF) = w; }
                    else { const u32x4 a = *(const u32x4*)(gp + bj * HALF);
                        f32x4 r0, r1;
                        r0[0] = bflo(a.x) * __builtin_amdgcn_rcpf(g0[0]); r0[1] = bfhi(a.x) * __builtin_amdgcn_rcpf(g0[1]); r0[2] = bflo(a.y) * __builtin_amdgcn_rcpf(g0[2]); r0[3] = bfhi(a.y) * __builtin_amdgcn_rcpf(g0[3]);
                        r1[0] = bflo(a.z) * __builtin_amdgcn_rcpf(g1[0]); r1[1] = bfhi(a.z) * __builtin_amdgcn_rcpf(g1[1]); r1[2] = bflo(a.w) * __builtin_amdgcn_rcpf(g1[2]); r1[3] = bfhi(a.w) * __builtin_amdgcn_rcpf(g1[3]);
                        acc[ai][bj][m][0] *= r0; acc[ai][bj][m][1] *= r1; } }
                if (m & 1) asm volatile("" ::: "memory"); }
    }
};
struct EpiProj {
    static constexpr bool PERM = true, AFTER_DRAIN = false;
    bf16_t* QK; bf16_t* G; const float* b_gate; const int* pos; bf16_t* VT;
    __device__ __forceinline__ void operator()(const f32x4 (&acc)[2][2][4][2], const Unit& u, int wr, int wc, int fr, int fq) const {
        if (u.pm < 0) {
            const int vr0 = (u.pm + 44) * BM + wr * 64 + fr, vc0 = (u.pn - 60) * BM + wc * 32 + 8 * fq;
#pragma unroll
            for (int ai = 0; ai < 2; ++ai)
#pragma unroll
                for (int m = 0; m < 4; ++m) { bf16_t* rowp = VT + (size_t)(vr0 + ai * HALF + m * 16) * 16384 + vc0;
#pragma unroll
                    for (int bj = 0; bj < 2; ++bj) { const f32x4 v0 = acc[ai][bj][m][0], v1 = acc[ai][bj][m][1];
                        u32x4 w; w.x = cvtpk(v0[0], v0[1]); w.y = cvtpk(v0[2], v0[3]); w.z = cvtpk(v1[0], v1[1]); w.w = cvtpk(v1[2], v1[3]);
                        *(u32x4*)(rowp + bj * HALF) = w; } }
            return;
        }
        const int row0 = u.pm * BM + wr * 64 + fr, colt = u.pn * BM, cl = wc * 32 + 8 * fq;
        if (colt >= 2048) {
            const int gc = colt - 2048 + cl;
            f32x4 bv[2][2];
#pragma unroll
            for (int bj = 0; bj < 2; ++bj)
#pragma unroll
                for (int n = 0; n < 2; ++n) bv[bj][n] = *(const f32x4*)(b_gate + gc + bj * HALF + 4 * n);
#pragma unroll
            for (int ai = 0; ai < 2; ++ai)
#pragma unroll
                for (int m = 0; m < 4; ++m) { bf16_t* rowp = G + (size_t)(row0 + ai * HALF + m * 16) * 2048 + gc;
#pragma unroll
                    for (int bj = 0; bj < 2; ++bj) { f32x4 v0 = acc[ai][bj][m][0] + bv[bj][0], v1 = acc[ai][bj][m][1] + bv[bj][1];
#pragma unroll
                        for (int k = 0; k < 4; ++k) { v0[k] = __builtin_amdgcn_rcpf(1.f + __expf(-v0[k])); v1[k] = __builtin_amdgcn_rcpf(1.f + __expf(-v1[k])); }
                        u32x4 w; w.x = cvtpk(v0[0], v0[1]); w.y = cvtpk(v0[2], v0[3]); w.z = cvtpk(v1[0], v1[1]); w.w = cvtpk(v1[2], v1[3]);
                        *(u32x4*)(rowp + bj * HALF) = w; } }
        } else if (colt >= 1024) {
            const float sc = (colt < 1536) ? C2 : 1.f;
            const int i0 = 16 * (wc & 1) + 4 * fq;
            float inv[4];
#pragma unroll
            for (int j = 0; j < 4; ++j) inv[j] = __builtin_amdgcn_exp2f(-(float)(i0 + j) * 0.41524101186092029f);
#pragma unroll
            for (int ai = 0; ai < 2; ++ai)
#pragma unroll
                for (int m = 0; m < 4; ++m) { const int row = row0 + ai * HALF + m * 16; const float p = (float)pos[row]; bf16_t* rowp = QK + (size_t)row * 2048 + colt + cl;
                    float cs[4], sn[4];
#pragma unroll
                    for (int j = 0; j < 4; ++j) { const float ang = p * inv[j]; const float k = rintf(ang * 0.15915494309189535f);
                        float r = fmaf(-k, 6.28125f, ang); r = fmaf(-k, 1.9353071795864769e-3f, r); cs[j] = __cosf(r) * sc; sn[j] = __sinf(r) * sc; }
#pragma unroll
                    for (int bj = 0; bj < 2; ++bj) { const f32x4 v0 = acc[ai][bj][m][0], v1 = acc[ai][bj][m][1];
                        u32x4 w;
                        w.x = cvtpk(v0[0] * cs[0] - v0[1] * sn[0], v0[0] * sn[0] + v0[1] * cs[0]);
                        w.y = cvtpk(v0[2] * cs[1] - v0[3] * sn[1], v0[2] * sn[1] + v0[3] * cs[1]);
                        w.z = cvtpk(v1[0] * cs[2] - v1[1] * sn[2], v1[0] * sn[2] + v1[1] * cs[2]);
                        w.w = cvtpk(v1[2] * cs[3] - v1[3] * sn[3], v1[2] * sn[3] + v1[3] * cs[3]);
                        *(u32x4*)(rowp + bj * HALF) = w; } }
        } else {
            const float sc = (colt < 512) ? C2 : 1.f;
#pragma unroll
            for (int ai = 0; ai < 2; ++ai)
#pragma unroll
                for (int m = 0; m < 4; ++m) { bf16_t* rowp = QK + (size_t)(row0 + ai * HALF + m * 16) * 2048 + colt + cl;
#pragma unroll
                    for (int bj = 0; bj < 2; ++bj) { const f32x4 v0 = acc[ai][bj][m][0] * sc, v1 = acc[ai][bj][m][1] * sc;
                        u32x4 w; w.x = cvtpk(v0[0], v0[1]); w.y = cvtpk(v0[2], v0[3]); w.z = cvtpk(v1[0], v1[1]); w.w = cvtpk(v1[2], v1[3]);
                        *(u32x4*)(rowp + bj * HALF) = w; } }
        }
    }
};

template <class E> struct EpiKeep { static __device__ __forceinline__ bool keep(const Unit&) { return false; } };
struct EpiGate;
template <> struct EpiKeep<EpiGate> { static __device__ __forceinline__ bool keep(const Unit& u) { return u.pm < 64; } };
template <class Epi, class Sched, bool ALIGN_EPI = false, bool SP2 = false>
__device__ __forceinline__ void gemm_phase(LAS unsigned char* lds, const Gemm g, const Sched& S, const Epi& E) {
    int tid = threadIdx.x; asm volatile("" : "+v"(tid));
    const int wid = __builtin_amdgcn_readfirstlane(tid >> 6), lane = tid & 63, wr = wid >> 2, wc = wid & 3, fr = lane & 15, fq = lane >> 4;
    const int K = g.K, nt = K / BK;
    unsigned voffA[2], voffB[2];
#pragma unroll
    for (int i = 0; i < 2; ++i) { int R, C; stage_rc(tid * 16 + i * 8192, R, C); const int Rb = Epi::PERM ? ((R & ~31) + perm32(R & 31)) : R;
        voffA[i] = (unsigned)(R * K + C) * 2u; voffB[i] = (unsigned)(Rb * K + C) * 2u; }
    const size_t kstep = (size_t)(BK * 2);
    const size_t hstep = (size_t)HALF * K * 2;
    const size_t tstep = 2 * hstep;
    const unsigned ldsw = (unsigned)wid * 1024u;
    const int aoff = lds_byte(wr * 64 + fr, fq * 8), boff = lds_byte(wc * 32 + fr, fq * 8);
#define PG8_SA(b, h) (((b) * 2 + (h)) * HTB)
#define PG8_SB(b, h) ((4 + (b) * 2 + (h)) * HTB)
#define PG8_STAGE(bufoff, gbase, voff) do { _Pragma("unroll") for (int _i = 0; _i < 2; ++_i) \
        __builtin_amdgcn_global_load_lds((const unsigned*)((const char*)(gbase) + (voff)[_i]), (LAS unsigned*)(lds + (bufoff) + ldsw + _i * 8192), 16, 0, 0); } while (0)
#define PG8_LDA(dst, b, h) do { _Pragma("unroll") for (int m = 0; m < 4; ++m) _Pragma("unroll") for (int k = 0; k < 2; ++k) dst[m][k] = *(const LAS bf16x8*)(lds + PG8_SA(b, h) + aoff + m * 2048 + k * 1024); } while (0)
#define PG8_LDB(dst, b, h) do { _Pragma("unroll") for (int n = 0; n < 2; ++n) _Pragma("unroll") for (int k = 0; k < 2; ++k) dst[n][k] = *(const LAS bf16x8*)(lds + PG8_SB(b, h) + boff + n * 2048 + k * 1024); } while (0)
#define PG8_MMA(ai, bj, At, Bt) do { __builtin_amdgcn_s_setprio(1); _Pragma("unroll") for (int m = 0; m < 4; ++m) _Pragma("unroll") for (int n = 0; n < 2; ++n) _Pragma("unroll") for (int k = 0; k < 2; ++k) \
        acc[ai][bj][m][n] = __builtin_amdgcn_mfma_f32_16x16x32_bf16(Bt[n][k], At[m][k], acc[ai][bj][m][n], 0, 0, 0); __builtin_amdgcn_s_setprio(0); } while (0)
#define PG8_WAIT_V(n) asm volatile("s_waitcnt vmcnt(" #n ")" ::: "memory")
#define PG8_WAIT_L(n) asm volatile("s_waitcnt lgkmcnt(" #n ")" ::: "memory")
#define PG8_BAR __builtin_amdgcn_s_barrier()
#define PG8_SCHED __builtin_amdgcn_sched_barrier(0)
    Unit cur, nxt; int ui = 0;
    if (!S.next(0, cur)) return;
    f32x4 acc[2][2][4][2];
#pragma unroll
    for (int a = 0; a < 2; ++a)
#pragma unroll
        for (int b = 0; b < 2; ++b)
#pragma unroll
            for (int m = 0; m < 4; ++m)
#pragma unroll
                for (int n = 0; n < 2; ++n) acc[a][b][m][n] = (f32x4){0.f, 0.f, 0.f, 0.f};
    bf16x8 At[4][2], B0[2][2], B1[2][2];
    const char* cA = (const char*)g.A + (size_t)cur.pm * tstep; const char* cB = (const char*)g.Bt + (size_t)cur.pn * tstep;
    S.a_ready(cur);
    if constexpr (SP2) {
        PG8_STAGE(PG8_SB(0, 0), cB, voffB); PG8_STAGE(PG8_SB(0, 1), cB + hstep, voffB); PG8_STAGE(PG8_SA(0, 0), cA, voffA); PG8_STAGE(PG8_SA(0, 1), cA + hstep, voffA);
        if (wr == 1) PG8_BAR;
        PG8_WAIT_V(2); PG8_BAR;
        PG8_STAGE(PG8_SB(1, 0), cB + kstep, voffB); PG8_STAGE(PG8_SA(1, 0), cA + kstep, voffA); PG8_STAGE(PG8_SB(1, 1), cB + hstep + kstep, voffB);
        PG8_WAIT_V(6); PG8_BAR;
    } else {
        PG8_STAGE(PG8_SB(0, 0), cB, voffB); PG8_STAGE(PG8_SA(0, 0), cA, voffA); PG8_STAGE(PG8_SB(0, 1), cB + hstep, voffB); PG8_STAGE(PG8_SA(0, 1), cA + hstep, voffA);
        if (wr == 1) PG8_BAR;
        PG8_WAIT_V(4); PG8_BAR;
        PG8_STAGE(PG8_SB(1, 0), cB + kstep, voffB); PG8_STAGE(PG8_SA(1, 0), cA + kstep, voffA); PG8_STAGE(PG8_SB(1, 1), cB + hstep + kstep, voffB);
        PG8_WAIT_V(6); PG8_BAR;
    }
    for (;;) {
        const bool has_next = S.next(ui + 1, nxt);
        const char* nA = has_next ? (const char*)g.A + (size_t)nxt.pm * tstep : cA; const char* nB = has_next ? (const char*)g.Bt + (size_t)nxt.pn * tstep : cB;
        for (int t = 0; t < nt; t += 2) {
            const bool last = (t == nt - 2);
            const char* a1 = cA + (size_t)(t + 1) * kstep;
            const char* a2 = last ? nA : cA + (size_t)(t + 2) * kstep; const char* b2 = last ? nB : cB + (size_t)(t + 2) * kstep;
            const char* a3 = a2 + kstep; const char* b3 = b2 + kstep;
            if (last && has_next) S.a_ready(nxt);
            if constexpr (SP2) {
            PG8_LDB(B0, 0, 0); PG8_LDB(B1, 0, 1); PG8_SCHED; PG8_LDA(At, 0, 0); PG8_STAGE(PG8_SA(1, 1), a1 + hstep, voffA);
            PG8_WAIT_V(8); PG8_WAIT_L(0); PG8_BAR; PG8_MMA(0, 0, At, B0); PG8_MMA(0, 1, At, B1); PG8_BAR; PG8_SCHED;
            PG8_LDA(At, 0, 1); PG8_STAGE(PG8_SB(0, 0), b2, voffB); PG8_STAGE(PG8_SB(0, 1), b2 + hstep, voffB); PG8_STAGE(PG8_SA(0, 0), a2, voffA);
            PG8_WAIT_V(8); PG8_WAIT_L(0); PG8_BAR; PG8_MMA(1, 0, At, B0); PG8_MMA(1, 1, At, B1); PG8_BAR; PG8_SCHED;
            PG8_LDB(B0, 1, 0); PG8_LDB(B1, 1, 1); PG8_SCHED; PG8_LDA(At, 1, 0); PG8_STAGE(PG8_SA(0, 1), a2 + hstep, voffA);
            PG8_WAIT_V(8); PG8_WAIT_L(0); PG8_BAR; PG8_MMA(0, 0, At, B0); PG8_MMA(0, 1, At, B1); PG8_BAR; PG8_SCHED;
            PG8_LDA(At, 1, 1); PG8_STAGE(PG8_SB(1, 0), b3, voffB); PG8_STAGE(PG8_SB(1, 1), b3 + hstep, voffB); PG8_STAGE(PG8_SA(1, 0), a3, voffA);
            PG8_WAIT_V(8); PG8_WAIT_L(0); PG8_BAR; PG8_MMA(1, 0, At, B0); PG8_MMA(1, 1, At, B1); PG8_BAR; PG8_SCHED;
            } else {
            PG8_LDB(B0, 0, 0); PG8_SCHED; PG8_LDA(At, 0, 0); PG8_STAGE(PG8_SA(1, 1), a1 + hstep, voffA);
            PG8_WAIT_L(8); PG8_BAR; PG8_WAIT_L(0); PG8_MMA(0, 0, At, B0); PG8_BAR; PG8_SCHED;
            PG8_LDB(B1, 0, 1); PG8_STAGE(PG8_SB(0, 0), b2, voffB);
            PG8_BAR; PG8_WAIT_L(0); PG8_MMA(0, 1, At, B1); PG8_BAR;
            PG8_LDA(At, 0, 1); PG8_STAGE(PG8_SA(0, 0), a2, voffA);
            PG8_BAR; PG8_WAIT_L(0); PG8_MMA(1, 0, At, B0); PG8_BAR; PG8_SCHED;
            PG8_STAGE(PG8_SB(0, 1), b2 + hstep, voffB);
            PG8_WAIT_V(6); PG8_BAR; PG8_MMA(1, 1, At, B1); PG8_BAR;
            PG8_LDB(B0, 1, 0); PG8_SCHED; PG8_LDA(At, 1, 0); PG8_STAGE(PG8_SA(0, 1), a2 + hstep, voffA);
            PG8_WAIT_L(8); PG8_BAR; PG8_WAIT_L(0); PG8_MMA(0, 0, At, B0); PG8_BAR; PG8_SCHED;
            PG8_LDB(B1, 1, 1); PG8_STAGE(PG8_SB(1, 0), b3, voffB);
            PG8_BAR; PG8_WAIT_L(0); PG8_MMA(0, 1, At, B1); PG8_BAR;
            PG8_LDA(At, 1, 1); PG8_STAGE(PG8_SA(1, 0), a3, voffA);
            PG8_BAR; PG8_WAIT_L(0); PG8_MMA(1, 0, At, B0); PG8_BAR; PG8_SCHED;
            PG8_STAGE(PG8_SB(1, 1), b3 + hstep, voffB);
            PG8_WAIT_V(6); PG8_BAR; PG8_MMA(1, 1, At, B1); PG8_BAR;
            }
        }
        if constexpr (ALIGN_EPI) { if (wr == 0) PG8_BAR; }
        if constexpr (!Epi::AFTER_DRAIN) { E(acc, cur, wr, wc, fr, fq); S.done(cur); }
        if (!has_next) break;
        if (!EpiKeep<Epi>::keep(cur)) {
#pragma unroll
        for (int a = 0; a < 2; ++a)
#pragma unroll
            for (int b = 0; b < 2; ++b)
#pragma unroll
                for (int m = 0; m < 4; ++m)
#pragma unroll
                    for (int n = 0; n < 2; ++n) acc[a][b][m][n] = (f32x4){0.f, 0.f, 0.f, 0.f};
        }
        cur = nxt; cA = nA; cB = nB; ++ui;
        if constexpr (ALIGN_EPI) { if (wr == 1) PG8_BAR; }
    }
    PG8_WAIT_V(0);
    if constexpr (!ALIGN_EPI) { if (wr == 0) PG8_BAR; }
    PG8_BAR;
#undef PG8_SA
#undef PG8_SB
#undef PG8_STAGE
#undef PG8_LDA
#undef PG8_LDB
#undef PG8_MMA
#undef PG8_WAIT_V
#undef PG8_WAIT_L
#undef PG8_BAR
#undef PG8_SCHED
}
}

namespace att {
constexpr int KROW = 144, VROW = 144, BUF = 36864, K2OFF = 9216, VOFF = 18432;
constexpr int QKP = 2048;
constexpr float SB_EXIT = 1.0e-38f;

__device__ __forceinline__ float partner(float v) {
    const unsigned own = __float_as_uint(v);
    auto rr = __builtin_amdgcn_permlane32_swap(own, own, false, false);
    const unsigned a = rr[0], b = rr[1];
    return __uint_as_float(a == own ? b : a);
}
__device__ __forceinline__ bf16x8 pack8(float a0, float a1, float a2, float a3, float a4, float a5, float a6, float a7) {
    u32x4 w; w.x = cvtpk(a0, a1); w.y = cvtpk(a2, a3); w.z = cvtpk(a4, a5); w.w = cvtpk(a6, a7); return __builtin_bit_cast(bf16x8, w);
}
#define MFMA32(a, b, c) __builtin_amdgcn_mfma_f32_32x32x16_bf16((a), (b), (c), 0, 0, 0)
__device__ __forceinline__ float max3f(float a, float b, float c) { float r; asm("v_max3_f32 %0, %1, %2, %3" : "=v"(r) : "v"(a), "v"(b), "v"(c)); return r; }
constexpr float DF_THR = 8.f;

constexpr int KBUF = 18432, VOFF0 = 2 * KBUF, VBUF = 128 * VROW, FLAGS_OFF = VOFF0 + 3 * VBUF;
template <bool DF>
__device__ __forceinline__ void attn_unit(LAS unsigned char* lds, const bf16_t* __restrict__ QK, const bf16_t* __restrict__ VT, bf16_t* __restrict__ Y,
                                          int b, int h, int qb, float lam, const float* __restrict__ g_subln) {
    int tid = threadIdx.x; asm volatile("" : "+v"(tid));
    const int lane = tid & 63, wid = __builtin_amdgcn_readfirstlane(tid >> 6), r32 = lane & 31, hi = lane >> 5;
    const int sub = wid >> 2, wq = wid & 3;
    const int t0 = qb * 128 + wq * 32;
    const size_t tokbase = (size_t)b * SEQ;
    const int qcol = (DF ? 1024 : 0) + (2 * h + sub) * 64;
    const int kcol = (DF ? 1536 : 512) + h * 128;
    const int vrow0 = (DF ? 512 : 0) + h * 128;
    constexpr int NC = 2;
    constexpr int ND = DF ? 4 : 2;
    const int jt = 2 * qb + 1, jd = t0 >> 6;

    const bf16_t* ksrc[NC]; const bf16_t* vsrc[NC]; unsigned kdst[NC], vdst[NC];
#pragma unroll
    for (int i = 0; i < NC; ++i) {
        const int cid = tid + 512 * i;
        { const int key = cid >> 4, c = cid & 15; ksrc[i] = QK + (tokbase + key) * QKP + kcol + 8 * c; kdst[i] = (unsigned)((c >> 3) * K2OFF + key * KROW + (c & 7) * 16); }
        const int d = cid >> 3, c = cid & 7; vsrc[i] = VT + (size_t)(vrow0 + d) * M + tokbase + 8 * c; vdst[i] = (unsigned)(VOFF0 + d * VROW + (c >> 1) * 32 + (c & 1) * 8);
    }
    u32x4 kA[NC], vA[NC], kB[NC], vB[NC];
#define ATT_GLOAD(KS, VS, j) do { _Pragma("unroll") for (int i_ = 0; i_ < NC; ++i_) { KS[i_] = *(const u32x4*)(ksrc[i_] + (size_t)(j) * 64 * QKP); VS[i_] = *(const u32x4*)(vsrc[i_] + (j) * 64); } } while (0)
#define ATT_LSTORE(kbo, vbo, KS, VS) do { _Pragma("unroll") for (int i_ = 0; i_ < NC; ++i_) { *(LAS u32x4*)(lds + (kbo) + kdst[i_]) = KS[i_]; \
        *(LAS u32x2*)(lds + (vbo) + vdst[i_]) = (u32x2){VS[i_].x, VS[i_].y}; *(LAS u32x2*)(lds + (vbo) + vdst[i_] + 16) = (u32x2){VS[i_].z, VS[i_].w}; } } while (0)
#define ATT_VFRAG(dst, vbase, dd0) do { _Pragma("unroll") for (int i_ = 0; i_ < 8; ++i_) dst[i_] = *(const LAS bf16x8*)((vbase) + ((dd0) + (i_ >> 2)) * 32 * VROW + (i_ & 3) * 32); } while (0)

    bf16x8 qf[4];
    { const bf16_t* Qp = QK + (tokbase + t0 + r32) * QKP + qcol + hi * 8;
#pragma unroll
      for (int d0 = 0; d0 < 4; ++d0) qf[d0] = *(const bf16x8*)(Qp + d0 * 16); }
    ATT_GLOAD(kA, vA, jt);
    ATT_GLOAD(kB, vB, jt - 1);
    f32x16 o[ND];
#pragma unroll
    for (int dd = 0; dd < ND; ++dd) o[dd] = f32x16{};
    float carry = DF ? 0.f : 1.f;
    float lsum = 0.f;
    f32x16 negm = f32x16{};
    bool first = true;
    ATT_LSTORE(0, 0, kA, vA);
#pragma unroll
    for (int d0 = 0; d0 < 4; ++d0) asm volatile("" : "+v"(qf[d0]));
    ATT_GLOAD(kA, vA, (jt >= 2 ? jt - 2 : 0));
    __syncthreads();

    if (wid >= 4) __builtin_amdgcn_s_setprio(1);
    bool done = false;
    volatile LAS unsigned* flags = (volatile LAS unsigned*)(lds + FLAGS_OFF);
    bf16x8 pk[4];
#pragma unroll
    for (int ks = 0; ks < 4; ++ks) pk[ks] = bf16x8{};
    int vcur = 0, vprev = 0;
    auto step = [&](const int j, const int kcur, u32x4 (&KS)[NC], u32x4 (&VS)[NC]) -> bool {
        const int vnext = (vcur == 2 * VBUF) ? 0 : vcur + VBUF;
        if (j <= jd && !done) {
            const LAS unsigned char* Kb = lds + kcur + sub * K2OFF + r32 * KROW + hi * 16;
            const LAS unsigned char* Vb = lds + VOFF0 + vcur + ((DF ? 0 : sub * 64) + r32) * VROW + hi * 16;
            f32x16 p0 = DF ? negm : f32x16{}, p1 = p0;
            bf16x8 kf[8];
#pragma unroll
            for (int d0 = 0; d0 < 4; ++d0) { kf[2 * d0] = *(const LAS bf16x8*)(Kb + d0 * 32); kf[2 * d0 + 1] = *(const LAS bf16x8*)(Kb + 32 * KROW + d0 * 32); }
            __builtin_amdgcn_sched_barrier(0);
#pragma unroll
            for (int d0 = 0; d0 < 4; ++d0) { p0 = MFMA32(kf[2 * d0], qf[d0], p0); p1 = MFMA32(kf[2 * d0 + 1], qf[d0], p1); }
            if (!DF) {
                float nb[32];
#pragma unroll
                for (int e = 0; e < 32; ++e) { const float z = e < 16 ? p0[e] : p1[e - 16];
                    nb[e] = __builtin_amdgcn_rcpf(1.f + __builtin_amdgcn_exp2f(z)); }
                if (j == jd) {
                    const int tq = t0 + r32 - 64 * j;
#pragma unroll
                    for (int e = 0; e < 32; ++e) { const int kk = (e & 3) + 8 * ((e & 15) >> 2) + 4 * hi + 32 * (e >> 4); const bool ok = kk < tq;
                        nb[e] = ok ? nb[e] : 1.f; }
                }
                float SI[9], SIp[9];
                SI[8] = 1.f; SIp[8] = 1.f;
#pragma unroll
                for (int i = 7; i >= 0; --i) SI[i] = SI[i + 1] * ((nb[4 * i] * nb[4 * i + 1]) * (nb[4 * i + 2] * nb[4 * i + 3]));
#pragma unroll
                for (int i = 0; i < 8; ++i) SIp[i] = partner(SI[i]);
                float w[32];
#pragma unroll
                for (int i = 0; i < 8; ++i) {
                    const float a3 = carry * SI[i + 1] * (hi ? SIp[i + 1] : SIp[i]);
                    const float a2 = a3 * nb[4 * i + 3], a1 = a2 * nb[4 * i + 2], a0 = a1 * nb[4 * i + 1], ae = a0 * nb[4 * i];
                    w[4 * i + 3] = a3 - a2; w[4 * i + 2] = a2 - a1; w[4 * i + 1] = a1 - a0; w[4 * i] = a0 - ae;
                }
                carry *= SI[0] * SIp[0];
                done = __all(carry < SB_EXIT);
                __builtin_amdgcn_sched_barrier(0);
                bf16x8 vfa[8];
                ATT_VFRAG(vfa, Vb, 0);
                bf16x8 pw[4];
#pragma unroll
                for (int ks = 0; ks < 4; ++ks) pw[ks] = pack8(w[8 * ks], w[8 * ks + 1], w[8 * ks + 2], w[8 * ks + 3], w[8 * ks + 4], w[8 * ks + 5], w[8 * ks + 6], w[8 * ks + 7]);
                __builtin_amdgcn_sched_barrier(0);
#pragma unroll
                for (int ks = 0; ks < 4; ++ks) { o[0] = MFMA32(vfa[ks], pw[ks], o[0]); o[1] = MFMA32(vfa[4 + ks], pw[ks], o[1]); }
            } else {
                const LAS unsigned char* Vp = lds + VOFF0 + vprev + r32 * VROW + hi * 16;
                float ra = max3f(p0[0], p0[1], p1[0]), rb = max3f(p0[2], p0[3], p1[1]); ra = max3f(ra, p1[2], p1[3]);
#pragma unroll
                for (int r = 4; r < 16; r += 4) { ra = max3f(ra, p0[r], p0[r + 1]); rb = max3f(rb, p0[r + 2], p0[r + 3]); ra = max3f(ra, p1[r], p1[r + 1]); rb = max3f(rb, p1[r + 2], p1[r + 3]); }
                float rm = max3f(ra, rb, rb); rm = max3f(rm, partner(rm), rm);
                const bool need = __any(rm > DF_THR) || first;
                float scl = 1.f;
                if (need) {
                    const float dl = first ? rm : fmaxf(rm, 0.f); carry += dl;
#pragma unroll
                    for (int r = 0; r < 16; ++r) { p0[r] -= dl; p1[r] -= dl; }
#pragma unroll
                    for (int r = 0; r < 16; ++r) negm[r] = -carry;
                    scl = first ? 1.f : __builtin_amdgcn_exp2f(-dl); lsum *= scl;
                    first = false;
                }
                bf16x8 vf[2][4];
#define ATT_VGRP(g) do { _Pragma("unroll") for (int dd_ = 0; dd_ < 4; ++dd_) vf[(g) & 1][dd_] = *(const LAS bf16x8*)(Vp + dd_ * 32 * VROW + (g) * 32); } while (0)
                ATT_VGRP(0);
                float sa = 0.f, sb = 0.f;
                u32x4 pnw[4];
                typedef __bf16 bf2_t __attribute__((ext_vector_type(2)));
                const bf2_t ones2 = {(__bf16)1.0f, (__bf16)1.0f};
#pragma unroll
                for (int i = 0; i < 16; ++i) {
                    __builtin_amdgcn_sched_barrier(0);
                    if ((i & 3) == 0 && i < 12) { ATT_VGRP((i >> 2) + 1); __builtin_amdgcn_sched_barrier(0); }
                    o[i & 3] = MFMA32(vf[(i >> 2) & 1][i & 3], pk[i >> 2], o[i & 3]);
                    __builtin_amdgcn_sched_barrier(0);
                    const int r0 = 2 * (i & 7);
                    const float e0 = __builtin_amdgcn_exp2f(i < 8 ? p0[r0] : p1[r0]), e1 = __builtin_amdgcn_exp2f(i < 8 ? p0[r0 + 1] : p1[r0 + 1]);
                    const unsigned w0 = cvtpk(e0, e1);
                    if (i & 1) sb = __builtin_amdgcn_fdot2_f32_bf16(__builtin_bit_cast(bf2_t, w0), ones2, sb, false);
                    else       sa = __builtin_amdgcn_fdot2_f32_bf16(__builtin_bit_cast(bf2_t, w0), ones2, sa, false);
                    pnw[i >> 2][i & 3] = w0;
                }
                __builtin_amdgcn_sched_barrier(0);
                float s = sa + sb;
                bf16x8 pn[4];
#pragma unroll
                for (int ks = 0; ks < 4; ++ks) pn[ks] = __builtin_bit_cast(bf16x8, pnw[ks]);
#pragma unroll
                for (int ks = 0; ks < 4; ++ks) asm volatile("" : "+v"(pn[ks]));
                asm volatile("" : "+v"(s));
                if (need) {
#pragma unroll
                    for (int dd = 0; dd < ND; ++dd)
#pragma unroll
                        for (int r = 0; r < 16; ++r) o[dd][r] *= scl;
                }
#pragma unroll
                for (int ks = 0; ks < 4; ++ks) pk[ks] = pn[ks];
                lsum += s;
            }
        }
        ATT_LSTORE(kcur ^ KBUF, vnext, KS, VS);
        ATT_GLOAD(KS, VS, (j > 3 ? j - 3 : 0));
        if (!DF) { if (lane == 0) flags[(kcur ? 8 : 0) + wid] = done ? 1u : 0u; }
        __syncthreads();
        vprev = vcur; vcur = vnext;
        if (!DF) {
            const u32x4 f0 = *(const LAS u32x4*)(lds + FLAGS_OFF + (kcur ? 32 : 0)), f1 = *(const LAS u32x4*)(lds + FLAGS_OFF + (kcur ? 32 : 0) + 16);
            if ((f0.x & f0.y & f0.z & f0.w & f1.x & f1.y & f1.z & f1.w) != 0u) return true;
        }
        return false;
    };
    for (int j = jt; j >= 0; j -= 2) {
        if (step(j, 0, kB, vB)) break;
        if (j == 0) break;
        if (step(j - 1, KBUF, kA, vA)) break;
    }
    if (DF) {
        const LAS unsigned char* Vp = lds + VOFF0 + vprev + r32 * VROW + hi * 16;
        bf16x8 vfa[8], vfb[8];
        ATT_VFRAG(vfa, Vp, 0); ATT_VFRAG(vfb, Vp, 2);
#pragma unroll
        for (int ks = 0; ks < 4; ++ks) { o[0] = MFMA32(vfa[ks], pk[ks], o[0]); o[1] = MFMA32(vfa[4 + ks], pk[ks], o[1]); }
#pragma unroll
        for (int ks = 0; ks < 4; ++ks) { o[ND - 2] = MFMA32(vfb[ks], pk[ks], o[ND - 2]); o[ND - 1] = MFMA32(vfb[4 + ks], pk[ks], o[ND - 1]); }
        __syncthreads();
    }
    __builtin_amdgcn_s_setprio(0);
#undef ATT_GLOAD
#undef ATT_LSTORE
#undef ATT_VFRAG
#undef ATT_VGRP
    if (!DF) {
        bf16_t* yp = Y + (tokbase + t0 + r32) * 512 + (2 * h + sub) * 64 + 4 * hi;
#pragma unroll
        for (int dd = 0; dd < ND; ++dd)
#pragma unroll
            for (int r4 = 0; r4 < 4; ++r4) { u32x2 w; w.x = cvtpk(o[dd][4 * r4], o[dd][4 * r4 + 1]); w.y = cvtpk(o[dd][4 * r4 + 2], o[dd][4 * r4 + 3]); *(u32x2*)(yp + dd * 32 + r4 * 8) = w; }
    } else {
        const float ltot = lsum + partner(lsum);
        const float inv = 1.f / ltot;
        LAS float* X = (LAS float*)lds + (size_t)wq * 4096;
        if (sub == 1) {
            const float f = lam * inv;
#pragma unroll
            for (int dd = 0; dd < ND; ++dd)
#pragma unroll
                for (int r = 0; r < 16; ++r) X[(dd * 32 + (r & 3) + 8 * (r >> 2) + 4 * hi) * 32 + r32] = o[dd][r] * f;
        }
        __syncthreads();
        if (sub == 0) {
            float ss = 0.f;
#pragma unroll
            for (int dd = 0; dd < ND; ++dd)
#pragma unroll
                for (int r = 0; r < 16; ++r) { const float v = o[dd][r] * inv - X[(dd * 32 + (r & 3) + 8 * (r >> 2) + 4 * hi) * 32 + r32]; o[dd][r] = v; ss += v * v; }
            ss += partner(ss);
            const float rstd = __builtin_amdgcn_rsqf(ss * (1.f / 128.f) + EPS) * (1.f - LAMBDA_INIT);
            bf16_t* yp = Y + (size_t)M * 512 + (tokbase + t0 + r32) * 512 + h * 128 + 4 * hi;
#pragma unroll
            for (int dd = 0; dd < ND; ++dd)
#pragma unroll
                for (int r4 = 0; r4 < 4; ++r4) { const f32x4 g = *(const f32x4*)(g_subln + dd * 32 + r4 * 8 + 4 * hi);
                    u32x2 w; w.x = cvtpk(o[dd][4 * r4] * rstd * g[0], o[dd][4 * r4 + 1] * rstd * g[1]); w.y = cvtpk(o[dd][4 * r4 + 2] * rstd * g[2], o[dd][4 * r4 + 3] * rstd * g[3]);
                    *(u32x2*)(yp + dd * 32 + r4 * 8) = w; }
        }
        __syncthreads();
    }
}
}


#define XB_TMO      128
#define XB_XCNT(j)  (256  + 64 * (j))
#define XB_XSUB(j)  (1280 + 64 * (j))
#define XB_XGEN(j)  (2304 + 64 * (j))
#define XB_TOP      3328
#define XB_TOPGEN   3392
#define XCD_BAR_WORDS 3456
#define XB_SPIN_CAP (1u << 21)
__device__ __forceinline__ unsigned xb_ld(unsigned* p)              { return __hip_atomic_load(p, __ATOMIC_RELAXED, __HIP_MEMORY_SCOPE_AGENT); }
__device__ __forceinline__ unsigned xb_add(unsigned* p, unsigned v) { return __hip_atomic_fetch_add(p, v, __ATOMIC_RELAXED, __HIP_MEMORY_SCOPE_AGENT); }
__device__ __forceinline__ unsigned xb_xcc_id() { return (unsigned)__builtin_amdgcn_s_getreg((3 << 11) | 20) & 0xFu; }
#define XB_SPIN(cond, bar) do { unsigned _sp = 0; while (cond) { __builtin_amdgcn_s_sleep(1); \
    if ((++_sp & 255u) == 0u) { if (xb_ld(&(bar)[XB_TMO])) break; if (_sp > XB_SPIN_CAP) { atomicAdd(&(bar)[XB_TMO], 1u); break; } } } } while (0)
struct XcdBarrier { unsigned* bar; unsigned x; volatile LAS unsigned* st; };
__device__ __forceinline__ XcdBarrier xcd_barrier_post(unsigned* bar, volatile LAS unsigned* st) {
    XcdBarrier b; b.bar = bar; b.x = xb_xcc_id(); b.st = st;
    if (threadIdx.x == 0) (void)xb_add(&bar[XB_XCNT(b.x)], 1u);
    return b;
}
__device__ __forceinline__ void xcd_barrier_complete(unsigned* bar, unsigned x, unsigned& nloc, unsigned& nx) {
    const unsigned G = gridDim.x * gridDim.y * gridDim.z;
    unsigned sum, cnt, mine, sp = 0u;
    for (;;) {
        sum = 0u; cnt = 0u; mine = 0u;
#pragma unroll
        for (unsigned j = 0; j < 16; ++j) { const unsigned c = xb_ld(&bar[XB_XCNT(j)]); sum += c; cnt += (c > 0u) ? 1u : 0u; mine = (j == x) ? c : mine; }
        if (sum == G) break;
        __builtin_amdgcn_s_sleep(1);
        if ((++sp & 255u) == 0u) { if (xb_ld(&bar[XB_TMO])) break; if (sp > XB_SPIN_CAP) { atomicAdd(&bar[XB_TMO], 1u); break; } }
    }
    nloc = mine > 0u ? mine : 1u; nx = cnt > 0u ? cnt : 1u;
}
__device__ __forceinline__ void xcd_barrier(const XcdBarrier& b) {
    asm volatile("s_waitcnt vmcnt(0)" ::: "memory");
    __syncthreads();
    if (threadIdx.x == 0) {
        unsigned* bar = b.bar;
        __builtin_amdgcn_s_waitcnt(0);
        unsigned nloc = b.st[0], nx = b.st[1];
        if (nloc == 0u) { xcd_barrier_complete(bar, b.x, nloc, nx); b.st[0] = nloc; b.st[1] = nx; }
        const unsigned old = xb_add(&bar[XB_XSUB(b.x)], 1u);
        const unsigned gen = old / nloc;
        if (old + 1u == (gen + 1u) * nloc) {
            __builtin_amdgcn_fence(__ATOMIC_RELEASE, "agent");
            asm volatile("s_waitcnt vmcnt(0)" ::: "memory");
            const unsigned og = xb_add(&bar[XB_TOP], 1u);
            const unsigned tg = og / nx;
            if (og + 1u == (tg + 1u) * nx) xb_add(&bar[XB_TOPGEN], 1u);
            else XB_SPIN(xb_ld(&bar[XB_TOPGEN]) == tg, bar);
            __builtin_amdgcn_fence(__ATOMIC_ACQUIRE, "agent");
            xb_add(&bar[XB_XGEN(b.x)], 1u);
            asm volatile("s_waitcnt vmcnt(0)" ::: "memory");
        } else {
            XB_SPIN(xb_ld(&bar[XB_XGEN(b.x)]) == gen, bar);
            __builtin_amdgcn_fence(__ATOMIC_ACQUIRE, "agent");
            asm volatile("s_waitcnt vmcnt(0)" ::: "memory");
        }
    }
    __syncthreads();
}

constexpr int NWAVES = 8, NPHASE = 10;
#ifndef PROBE_REPS
#define PROBE_REPS 0
#define PROBE_MASK 0x8
#endif
constexpr int LDS_BYTES = 147456;
constexpr int MISC_OFF = 131072;

struct Args { const void* in[22]; float* out; unsigned char* ws; int ph_lo, ph_hi; };

__device__ __forceinline__ float wave_sum(float v) {
#pragma unroll
    for (int o = 1; o < 64; o <<= 1) v += __shfl_xor(v, o);
    return v;
}
template <int MAP> __device__ __forceinline__ int rowmap(int n) {
    if (MAP == 0) return n;
    if (MAP == 2) return 2048 + n;
    const int sec = n >> 9, r = n & 511;
    if (sec <= 1) return n;
    if (sec == 2) return 4096 + r;
    if (sec == 5) return 4608 + r;
    const int e = r >> 6, d = r & 63, p = (d < 32) ? 2 * d : 2 * (d - 32) + 1;
    return (sec == 3 ? 1024 : 1536) + e * 64 + p;
}
template <int MAP> __device__ __forceinline__ void transpose_item(const float* __restrict__ W, int K, int N, bf16_t* __restrict__ WT, LAS float* scr, int item, int lane) {
    const int nblk = N / 32, kb = item / nblk, nb = item % nblk, k0 = 64 * kb, n0 = 32 * nb;
    { const int kk0 = lane >> 3, c4 = lane & 7; f32x4 v[8];
#pragma unroll
      for (int i = 0; i < 8; ++i) v[i] = *(const f32x4*)(W + (size_t)(k0 + kk0 + 8 * i) * N + n0 + 4 * c4);
#pragma unroll
      for (int i = 0; i < 8; ++i) { LAS float* p = scr + (kk0 + 8 * i) * 33 + 4 * c4; p[0] = v[i].x; p[1] = v[i].y; p[2] = v[i].z; p[3] = v[i].w; } }
    asm volatile("s_waitcnt lgkmcnt(0)" ::: "memory");
    const int c = lane & 7;
#pragma unroll
    for (int j = 0; j < 4; ++j) { const int n = (lane >> 3) + 8 * j; const LAS float* s = scr + (8 * c) * 33 + n;
        u32x4 o; o.x = cvtpk(s[0 * 33], s[1 * 33]); o.y = cvtpk(s[2 * 33], s[3 * 33]); o.z = cvtpk(s[4 * 33], s[5 * 33]); o.w = cvtpk(s[6 * 33], s[7 * 33]);
        *(u32x4*)(WT + (size_t)rowmap<MAP>(n0 + n) * K + k0 + 8 * c) = o; }
    asm volatile("s_waitcnt lgkmcnt(0)" ::: "memory");
}

__global__ void __launch_bounds__(NWAVES * 64, 2) fwd_kernel(Args args) {
    extern __shared__ __attribute__((aligned(16))) unsigned char lds_raw[];
    LAS unsigned char* lds = (LAS unsigned char*)lds_raw;
    const int tid0 = threadIdx.x, wave = __builtin_amdgcn_readfirstlane(tid0 >> 6);
    const int G = gridDim.x, bx = blockIdx.x;
    const int vcu = (G % 8 == 0) ? (bx % 8) * (G / 8) + bx / 8 : bx;
    const int gw = vcu * NWAVES + wave, NGW = G * NWAVES;

    const float* x = (const float*)args.in[0]; const float* cc = (const float*)args.in[1]; const int* pos = (const int*)args.in[2];
    const float* w_ada = (const float*)args.in[3]; const float* b_ada = (const float*)args.in[4]; const float* g_pre_mix = (const float*)args.in[5];
    const float* w_in = (const float*)args.in[6];
    const float* lq1 = (const float*)args.in[7]; const float* lk1 = (const float*)args.in[8]; const float* lq2 = (const float*)args.in[9]; const float* lk2 = (const float*)args.in[10];
    const float* g_subln = (const float*)args.in[11]; const float* w_bsb = (const float*)args.in[12]; const float* w_bdf = (const float*)args.in[13];
    const float* w_gate = (const float*)args.in[14]; const float* b_gate = (const float*)args.in[15]; const float* w_out = (const float*)args.in[16];
    const float* g_post_mix = (const float*)args.in[17]; const float* g_pre_ffn = (const float*)args.in[18];
    const float* w_ff1 = (const float*)args.in[19]; const float* w_ff2 = (const float*)args.in[20]; const float* g_post_ffn = (const float*)args.in[21];
    float* out = args.out; unsigned char* ws = args.ws;
    float* mod = (float*)(ws + CTL_MOD); float* rss1 = (float*)(ws + CTL_RSS1); float* rss2 = (float*)(ws + CTL_RSS2); unsigned* queue = (unsigned*)(ws + CTL_QUEUE);
    float* rss3 = (float*)(ws + CTL_RSS3); unsigned* pcnt = (unsigned*)(ws + CTL_PCNT);
#define fused ({ int g_ = (int)gridDim.x; asm volatile("" : "+s"(g_)); g_ == 256; })
    bf16_t* WCAT = (bf16_t*)(ws + WS_WCAT); bf16_t* WBSB = (bf16_t*)(ws + WS_WBSB); bf16_t* WBDF = (bf16_t*)(ws + WS_WBDF); bf16_t* WOUT = (bf16_t*)(ws + WS_WOUT);
    bf16_t* WFF1 = (bf16_t*)(ws + WS_WFF1); bf16_t* WFF2 = (bf16_t*)(ws + WS_WFF2);
    bf16_t* BUFA = (bf16_t*)(ws + WS_BUFA); bf16_t* QK = (bf16_t*)(ws + WS_QK); bf16_t* GATE = (bf16_t*)(ws + WS_GATE); bf16_t* FB = (bf16_t*)(ws + WS_F);
    bf16_t* VT = (bf16_t*)(ws + WS_VT); bf16_t* MB = (bf16_t*)(ws + WS_VT); bf16_t* MG = (bf16_t*)(ws + WS_MG); bf16_t* F2 = (bf16_t*)(ws + WS_MG);

    cg::grid_group grid = cg::this_grid();
    const int lo = args.ph_lo, hi_ph = args.ph_hi;
    if (tid0 < 64) ((LAS unsigned*)(lds + MISC_OFF))[tid0] = 0u;
    __syncthreads();
    const XcdBarrier bar = xcd_barrier_post((unsigned*)(ws + CTL_BAR), (volatile LAS unsigned*)(lds + MISC_OFF + 32));
#define GRID_BAR() do { if (lo < 0) grid.sync(); else xcd_barrier(bar); } while (0)
    using SO = pg8::StaticOrder;

    for (int ph = lo; ph < hi_ph; ++ph) {
#if PROBE_REPS
      for (int rep = 0; rep <= ((((PROBE_MASK) >> ph) & 1) ? PROBE_REPS : 0); ++rep) {
        if (rep) GRID_BAR();
#else
      { const int rep = 0;
#endif
        int tid = tid0; asm volatile("" : "+v"(tid));
        const int lane = tid & 63;
        if (ph == 0) {
            const bool gemv = bx < 96;
            for (int cgi = bx; cgi < 96; cgi += G) {
                LAS float* sc = (LAS float*)lds;
                for (int i = tid; i < 4096; i += 512) { const float cv = cc[i]; sc[i] = cv / (1.f + __expf(-cv)); }
                __syncthreads();
                const int col = 64 * cgi + lane; const float* wp = w_ada + (size_t)(128 * wave) * 6144 + col;
                float a0 = 0.f, a1 = 0.f, a2 = 0.f, a3 = 0.f;
#pragma unroll 1
                for (int d0 = 0; d0 < 128; d0 += 32) { float wv[32];
#pragma unroll
                    for (int dd = 0; dd < 32; ++dd) wv[dd] = wp[(size_t)(d0 + dd) * 6144];
#pragma unroll
                    for (int dd = 0; dd < 32; ++dd) { const int d = 128 * wave + d0 + dd; a0 += wv[dd] * sc[d]; a1 += wv[dd] * sc[1024 + d]; a2 += wv[dd] * sc[2048 + d]; a3 += wv[dd] * sc[3072 + d]; } }
                LAS float* part = (LAS float*)(lds + 16384) + wave * 256;
                part[lane] = a0; part[64 + lane] = a1; part[128 + lane] = a2; part[192 + lane] = a3;
                __syncthreads();
                if (tid < 256) { float sum = b_ada[64 * cgi + (tid & 63)];
#pragma unroll
                    for (int w_ = 0; w_ < 8; ++w_) sum += ((LAS float*)(lds + 16384))[w_ * 256 + tid];
                    mod[(tid >> 6) * 6144 + 64 * cgi + (tid & 63)] = sum; }
                __syncthreads();
            }
            { LAS float* scr = (LAS float*)(lds + wave * 16384);
              constexpr int I_IN = 16 * 96, I_GATE = 16 * 64, I_BS = 8 * 32, I_OUT = 16 * 32, I_FF1 = 16 * 128, I_FF2 = 64 * 32;
              constexpr int NITEMS = I_IN + I_GATE + 2 * I_BS + I_OUT + I_FF1 + I_FF2;
              constexpr int NSLOT = 160 * 16 + 96 * 8;
              const int slot0 = gemv ? 2560 + bx * 8 + wave : (bx - 96) * 16 + wave * 2, nsl = gemv ? 1 : 2;
              if (G == 256) {
                for (int base = slot0; base < NITEMS; base += NSLOT)
                  for (int q_ = 0; q_ < nsl; ++q_) { int r = base + q_; if (r >= NITEMS) break;
                    if (r < I_IN) { transpose_item<1>(w_in, 1024, 3072, WCAT, scr, r, lane); continue; } r -= I_IN;
                    if (r < I_GATE) { transpose_item<2>(w_gate, 1024, 2048, WCAT, scr, r, lane); continue; } r -= I_GATE;
                    if (r < I_BS) { transpose_item<0>(w_bsb, 512, 1024, WBSB, scr, r, lane); continue; } r -= I_BS;
                    if (r < I_BS) { transpose_item<0>(w_bdf, 512, 1024, WBDF, scr, r, lane); continue; } r -= I_BS;
                    if (r < I_OUT) { transpose_item<0>(w_out, 1024, 1024, WOUT, scr, r, lane); continue; } r -= I_OUT;
                    if (r < I_FF1) { transpose_item<0>(w_ff1, 1024, 4096, WFF1, scr, r, lane); continue; } r -= I_FF1;
                    transpose_item<0>(w_ff2, 4096, 1024, WFF2, scr, r, lane); }
              } else {
                for (int it = gw; it < NITEMS; it += NGW) { int r = it;
                    if (r < I_IN) { transpose_item<1>(w_in, 1024, 3072, WCAT, scr, r, lane); continue; } r -= I_IN;
                    if (r < I_GATE) { transpose_item<2>(w_gate, 1024, 2048, WCAT, scr, r, lane); continue; } r -= I_GATE;
                    if (r < I_BS) { transpose_item<0>(w_bsb, 512, 1024, WBSB, scr, r, lane); continue; } r -= I_BS;
                    if (r < I_BS) { transpose_item<0>(w_bdf, 512, 1024, WBDF, scr, r, lane); continue; } r -= I_BS;
                    if (r < I_OUT) { transpose_item<0>(w_out, 1024, 1024, WOUT, scr, r, lane); continue; } r -= I_OUT;
                    if (r < I_FF1) { transpose_item<0>(w_ff1, 1024, 4096, WFF1, scr, r, lane); continue; } r -= I_FF1;
                    transpose_item<0>(w_ff2, 4096, 1024, WFF2, scr, r, lane); }
              } }
        } else if (ph == 1) {
            for (int m0 = gw * 8; m0 < M; m0 += NGW * 8) {
                const float* mb = mod + (m0 >> 12) * 6144;
                f32x4 ga[4], sh[4];
#pragma unroll
                for (int j = 0; j < 4; ++j) { const int col = 4 * lane + 256 * j; ga[j] = *(const f32x4*)(g_pre_mix + col) * (*(const f32x4*)(mb + 1024 + col) + 1.f); sh[j] = *(const f32x4*)(mb + col); }
                f32x4 nv[4];
#pragma unroll
                for (int j = 0; j < 4; ++j) nv[j] = ((const f32x4*)(x + (size_t)m0 * DM) + lane)[64 * j];
#pragma unroll 2
                for (int r = 0; r < 8; ++r) { const int m = m0 + r;
                    f32x4 v[4]; float s = 0.f;
#pragma unroll
                    for (int j = 0; j < 4; ++j) v[j] = nv[j];
                    if (r < 7) {
#pragma unroll
                        for (int j = 0; j < 4; ++j) nv[j] = ((const f32x4*)(x + (size_t)(m + 1) * DM) + lane)[64 * j]; }
#pragma unroll
                    for (int j = 0; j < 4; ++j) s += (v[j].x * v[j].x + v[j].y * v[j].y) + (v[j].z * v[j].z + v[j].w * v[j].w);
                    const float rstd = __builtin_amdgcn_rsqf(wave_sum(s) * (1.f / DM) + EPS);
                    u32x2* o8 = (u32x2*)(BUFA + (size_t)m * DM) + lane;
#pragma unroll
                    for (int j = 0; j < 4; ++j) { const f32x4 hv = v[j] * rstd * ga[j] + sh[j]; o8[64 * j] = (u32x2){cvtpk(hv.x, hv.y), cvtpk(hv.z, hv.w)}; }
                }
            }
        } else if (ph == 2) {
            static_assert((WS_WCAT + (size_t)4096 * 1024 * 2) + 44 * (size_t)(256 * 1024 * 2) == WS_BUFA && WS_WCAT + 60 * (size_t)(256 * 1024 * 2) == WS_BUFA, "V^T units address Wv / h as tiles of the h / W base pointers");
            if (G == 256) {
                pg8::Gemm g{BUFA, WCAT, M, 4096, 1024}; pg8::TwoOrder S; S.a.init(M, 4096, G, bx); S.b.init(1024, M, G, bx); S.na = 4; S.dpm = -44; S.dpn = 60;
                pg8::EpiProj E{QK, GATE, b_gate, pos, VT};
                pg8::gemm_phase<pg8::EpiProj, pg8::TwoOrder, true, true>(lds, g, S, E);
            } else {
            { pg8::Gemm g{BUFA, WCAT, M, 4096, 1024}; SO S; S.init(M, 4096, G, bx); pg8::EpiProj E{QK, GATE, b_gate, pos, VT};
              pg8::gemm_phase<pg8::EpiProj, SO, true, true>(lds, g, S, E); }
            { pg8::Gemm g{WCAT + (size_t)4096 * 1024, BUFA, 1024, M, 1024}; SO S; S.init(1024, M, G, bx); pg8::EpiPlain E{VT, M};
              pg8::gemm_phase<pg8::EpiPlain, SO, true, true>(lds, g, S, E); }
            }
        } else if (ph == 3) {
            float lam;
            { const float s1 = wave_sum(lq1[lane] * lk1[lane]), s2 = wave_sum(lq2[lane] * lk2[lane]); lam = __expf(s1) - __expf(s2) + LAMBDA_INIT; }
            volatile LAS unsigned* uword = (volatile LAS unsigned*)(lds + MISC_OFF);
            for (;;) {
                if (tid == 0) uword[0] = atomicAdd(queue + rep, 1u);
                __syncthreads();
                const unsigned idx = uword[0];
                __syncthreads();
                if (idx >= 1024u) break;
                if (idx < 512u) { const int r2 = idx & 15; att::attn_unit<true>(lds, QK, VT, BUFA, r2 >> 2, r2 & 3, 31 - (int)(idx >> 4), lam, g_subln); }
                else { const int i2 = idx - 512, r2 = i2 & 15; att::attn_unit<false>(lds, QK, VT, BUFA, r2 >> 2, r2 & 3, 31 - (i2 >> 4), 0.f, g_subln); }
            }
        } else if (ph == 4) {
            static_assert(WS_WBDF == WS_WBSB + (size_t)1024 * 512 * 2, "branch weights adjacent");
            pg8::Gemm g{BUFA, WBSB, M, 1024, 512}; pg8::PairOrder S; S.a.init(M, 1024, G, bx); S.dpm = 64; S.dpn = 4;
            pg8::EpiGate E{MG, GATE};
            pg8::gemm_phase<pg8::EpiGate, pg8::PairOrder, true, true>(lds, g, S, E);
        } else if (ph == 5) {
            pg8::Gemm g{MG, WOUT, M, 1024, 1024}; SO S; S.init(M, 1024, G, bx);
            if (fused) { pg8::EpiMid E{x, MB, BUFA, mod, g_post_mix, g_pre_ffn, pg8::PanelX{rss1, pcnt}, pg8::PanelX{rss3, pcnt + 4096}};
                pg8::gemm_phase<pg8::EpiMid, SO, true, true>(lds, g, S, E); }
            else { pg8::EpiSumsq E{MB, 1024, rss1}; pg8::gemm_phase<pg8::EpiSumsq, SO, true, true>(lds, g, S, E); }
        } else if (ph == 6 && !fused) {
            f32x4 nx[4]; u32x2 nm[4]; float nrs = rss1[gw];
#pragma unroll
            for (int j = 0; j < 4; ++j) { nx[j] = ((const f32x4*)(x + (size_t)gw * DM) + lane)[64 * j]; nm[j] = ((const u32x2*)(MB + (size_t)gw * DM) + lane)[64 * j]; }
            for (int m = gw; m < M; m += NGW) {
                const float* mb = mod + (m >> 12) * 6144;
                const float rm = __builtin_amdgcn_rsqf(nrs * (1.f / DM) + EPS);
                f32x4* xo = (f32x4*)(out + (size_t)m * DM) + lane;
                f32x4 xv[4]; u32x2 mvv[4];
#pragma unroll
                for (int j = 0; j < 4; ++j) { xv[j] = nx[j]; mvv[j] = nm[j]; }
                if (m + NGW < M) { nrs = rss1[m + NGW];
#pragma unroll
                    for (int j = 0; j < 4; ++j) { nx[j] = ((const f32x4*)(x + (size_t)(m + NGW) * DM) + lane)[64 * j]; nm[j] = ((const u32x2*)(MB + (size_t)(m + NGW) * DM) + lane)[64 * j]; } }
                f32x4 v[4]; float s = 0.f;
#pragma unroll
                for (int j = 0; j < 4; ++j) { const int col = 4 * lane + 256 * j; const u32x2 mv = mvv[j];
                    const f32x4 mf = {bflo(mv.x), bfhi(mv.x), bflo(mv.y), bfhi(mv.y)};
                    const f32x4 g = *(const f32x4*)(g_post_mix + col), gt = *(const f32x4*)(mb + 2048 + col);
                    v[j] = xv[j] + gt * (mf * rm * g); xo[64 * j] = v[j];
                    s += (v[j].x * v[j].x + v[j].y * v[j].y) + (v[j].z * v[j].z + v[j].w * v[j].w); }
                const float rstd = __builtin_amdgcn_rsqf(wave_sum(s) * (1.f / DM) + EPS);
                u32x2* o8 = (u32x2*)(BUFA + (size_t)m * DM) + lane;
#pragma unroll
                for (int j = 0; j < 4; ++j) { const int col = 4 * lane + 256 * j;
                    const f32x4 g = *(const f32x4*)(g_pre_ffn + col), sh = *(const f32x4*)(mb + 3072 + col), sc = *(const f32x4*)(mb + 4096 + col);
                    const f32x4 hv = v[j] * rstd * g * (sc + 1.f) + sh;
                    o8[64 * j] = (u32x2){cvtpk(hv.x, hv.y), cvtpk(hv.z, hv.w)}; }
            }
        } else if (ph == 7) {
            pg8::Gemm g{BUFA, WFF1, M, FF, 1024}; SO S; S.init(M, FF, G, bx); pg8::EpiRelu2 E{FB, FF};
            pg8::gemm_phase<pg8::EpiRelu2, SO, true, true>(lds, g, S, E);
        } else if (ph == 8) {
            pg8::Gemm g{FB, WFF2, M, 1024, FF}; SO S; S.init(M, 1024, G, bx);
            if (fused) { pg8::EpiFinal E{out, MB, mod, g_post_ffn, pg8::PanelX{rss2, pcnt + 8192}}; pg8::gemm_phase<pg8::EpiFinal, SO, true, true>(lds, g, S, E); }
            else { pg8::EpiSumsq E{F2, 1024, rss2}; pg8::gemm_phase<pg8::EpiSumsq, SO, true, true>(lds, g, S, E); }
        } else if (ph == 9 && !fused) {
            f32x4 nx[4]; u32x2 nm[4]; float nrs = rss2[gw];
#pragma unroll
            for (int j = 0; j < 4; ++j) { nx[j] = ((const f32x4*)(out + (size_t)gw * DM) + lane)[64 * j]; nm[j] = ((const u32x2*)(F2 + (size_t)gw * DM) + lane)[64 * j]; }
            for (int m = gw; m < M; m += NGW) {
                const float* mb = mod + (m >> 12) * 6144;
                const float rm = __builtin_amdgcn_rsqf(nrs * (1.f / DM) + EPS);
                f32x4* xo = (f32x4*)(out + (size_t)m * DM) + lane;
                f32x4 xv[4]; u32x2 mvv[4];
#pragma unroll
                for (int j = 0; j < 4; ++j) { xv[j] = nx[j]; mvv[j] = nm[j]; }
                if (m + NGW < M) { nrs = rss2[m + NGW];
#pragma unroll
                    for (int j = 0; j < 4; ++j) { nx[j] = ((const f32x4*)(out + (size_t)(m + NGW) * DM) + lane)[64 * j]; nm[j] = ((const u32x2*)(F2 + (size_t)(m + NGW) * DM) + lane)[64 * j]; } }
#pragma unroll
                for (int j = 0; j < 4; ++j) { const int col = 4 * lane + 256 * j; const u32x2 mv = mvv[j];
                    const f32x4 mf = {bflo(mv.x), bfhi(mv.x), bflo(mv.y), bfhi(mv.y)};
                    const f32x4 g = *(const f32x4*)(g_post_ffn + col), gt = *(const f32x4*)(mb + 5120 + col);
                    xo[64 * j] = xv[j] + gt * (mf * rm * g); }
            }
        }
      }
        if (ph + 1 < hi_ph && !(fused && (ph == 5 || ph == 8))) GRID_BAR();
    }
}

#ifndef N_LAUNCH_PER_PHASE
#define N_LAUNCH_PER_PHASE 0
#endif

extern "C" void kernel_launch(void* const* d_in, const int* in_sizes, int n_in, void* d_out, int out_size, void* d_ws, size_t ws_size, hipStream_t stream) {
    static int grid = 0;
    if (grid == 0) {
        if (n_in != 22 || ws_size < WS_END) { fprintf(stderr, "kernel_launch: unexpected n_in %d / ws %zu\n", n_in, ws_size); grid = -1; return; }
        int dev = 0, cus = 0, per_cu = 0;
        hipGetDevice(&dev); hipDeviceGetAttribute(&cus, hipDeviceAttributeMultiprocessorCount, dev);
        hipFuncSetAttribute((const void*)fwd_kernel, hipFuncAttributeMaxDynamicSharedMemorySize, LDS_BYTES);
        hipOccupancyMaxActiveBlocksPerMultiprocessor(&per_cu, (const void*)fwd_kernel, NWAVES * 64, LDS_BYTES);
        if (per_cu < 1) per_cu = 1;
        grid = cus * per_cu;
        (void)hipGetLastError();
    }
    if (grid < 0) return;
    hipMemsetAsync((char*)d_ws + WS_CTL, 0, CTL_ZERO_BYTES, stream);
    Args a{};
    for (int i = 0; i < 22; ++i) a.in[i] = d_in[i];
    a.out = (float*)d_out; a.ws = (unsigned char*)d_ws;
#if N_LAUNCH_PER_PHASE
    for (int p = 0; p < NPHASE; ++p) {
        a.ph_lo = p; a.ph_hi = p + 1;
        void* kargs[] = {&a};
        hipError_t e = hipLaunchCooperativeKernel((const void*)fwd_kernel, dim3(grid), dim3(NWAVES * 64), kargs, LDS_BYTES, stream);
        if (e != hipSuccess) { fprintf(stderr, "cooperative launch failed: %s (grid %d)\n", hipGetErrorString(e), grid); break; }
    }
#else
    a.ph_lo = 0; a.ph_hi = NPHASE;
    void* kargs[] = {&a};
    hipError_t e = hipLaunchCooperativeKernel((const void*)fwd_kernel, dim3(grid), dim3(NWAVES * 64), kargs, LDS_BYTES, stream);
    if (e != hipSuccess) fprintf(stderr, "cooperative launch failed: %s (grid %d)\n", hipGetErrorString(e), grid);
#endif
}
```
